# Optimizing an MI355X kernel written in HIP

```python
import math
import jax, jax.numpy as jnp
from jax import lax
import numpy as np

D_MODEL = 1024
BATCH = 2
SEQ = 8192
DEPTH = 1

MEM_LEN = 256
EPS = 1e-6
CONV_K = 4
GDN_HEADS = 8
GDN_DK = 128
GDN_DV = 128
GDN_DIM = GDN_HEADS * GDN_DV
GDN_CHUNK = 64
GDN_COLS = 4 * GDN_DIM + 2 * GDN_HEADS
SSM_DIM = D_MODEL
SSM_HEADDIM = 64
SSM_HEADS = SSM_DIM // SSM_HEADDIM
SSM_GROUPS = 2
SSM_HPG = SSM_HEADS // SSM_GROUPS
SSM_STATE = 128
SSM_CHUNK = 128
SSM_BC = SSM_GROUPS * SSM_STATE
SSM_COLS = 2 * SSM_DIM + 2 * SSM_BC + SSM_HEADS
MIX_DIM = GDN_DIM + SSM_DIM
IN_COLS = GDN_COLS + SSM_COLS
MEM_HEADS = 4
MEM_HEADDIM = D_MODEL // MEM_HEADS
D_FF = 4 * D_MODEL

kernel_name = "hybrid_gdn_ssd_parallel_heads_memxattn"


def rmsnorm(x, w):
    xf = x.astype(jnp.float32)
    y = xf * lax.rsqrt(jnp.mean(xf * xf, axis=-1, keepdims=True) + EPS)
    return (y * w.astype(jnp.float32)).astype(x.dtype)


def l2norm(x):
    return x * lax.rsqrt(jnp.sum(x * x, axis=-1, keepdims=True) + EPS)


def causal_depthwise_conv(x, w, b=None):
    K, C = w.shape
    xp = jnp.pad(x, ((0, 0), (K - 1, 0), (0, 0)))
    y = lax.conv_general_dilated(xp, w[:, None, :].astype(x.dtype), window_strides=(1,),
                                 padding='VALID', dimension_numbers=('NWC', 'WIO', 'NWC'),
                                 feature_group_count=C)
    if b is not None:
        y = y + b.astype(x.dtype)
    return y


def gated_delta_rule_chunked(q, k, v, g, beta):
    Bsz, T, H, Dk = q.shape
    Dv = v.shape[-1]
    C = GDN_CHUNK
    N = T // C
    q = l2norm(q) * (Dk ** -0.5)
    k = l2norm(k)

    def chunks(t):
        return t.reshape(Bsz, N, C, H, -1).transpose(0, 3, 1, 2, 4)

    q, k, v = chunks(q), chunks(k), chunks(v)
    g = g.reshape(Bsz, N, C, H).transpose(0, 3, 1, 2)
    beta = beta.reshape(Bsz, N, C, H).transpose(0, 3, 1, 2)
    g_cs = jnp.cumsum(g, axis=-1)
    causal = jnp.tril(jnp.ones((C, C), dtype=bool))
    strict = jnp.tril(jnp.ones((C, C), dtype=bool), -1)
    decay = jnp.exp(jnp.where(causal, g_cs[..., :, None] - g_cs[..., None, :], -jnp.inf))
    k_beta = k * beta[..., None]
    v_beta = v * beta[..., None]
    Lmat = jnp.where(strict, jnp.einsum('bhncd,bhnsd->bhncs', k_beta, k) * decay, 0.0)
    Amat = Lmat + jnp.eye(C, dtype=jnp.float32)
    rhs = jnp.concatenate([v_beta, k_beta * jnp.exp(g_cs)[..., None]], axis=-1)
    sol = lax.linalg.triangular_solve(Amat, rhs, left_side=True, lower=True, unit_diagonal=True)
    u = sol[..., :Dv]
    w = sol[..., Dv:]
    attn_intra = jnp.einsum('bhncd,bhnsd->bhncs', q, k) * decay
    q_dec = q * jnp.exp(g_cs)[..., None]
    k_dec = k * jnp.exp(g_cs[..., -1:] - g_cs)[..., None]
    chunk_decay = jnp.exp(g_cs[..., -1])

    def step(S, inp):
        qd, kd, u_c, w_c, a_c, cd = inp
        v_new = u_c - jnp.einsum('bhcd,bhde->bhce', w_c, S)
        o = jnp.einsum('bhcd,bhde->bhce', qd, S) + jnp.einsum('bhcs,bhse->bhce', a_c, v_new)
        S = S * cd[..., None, None] + jnp.einsum('bhcd,bhce->bhde', kd, v_new)
        return S, o

    mv = lambda t: jnp.moveaxis(t, 2, 0)
    S0 = jnp.zeros((Bsz, H, Dk, Dv), jnp.float32)
    _, o = lax.scan(step, S0, (mv(q_dec), mv(k_dec), mv(u), mv(w), mv(attn_intra), mv(chunk_decay)))
    return o.transpose(1, 0, 3, 2, 4).reshape(Bsz, T, H, Dv)


def gdn_mixer(p, conv_w, a_log, dt_bias, norm_w):
    Bsz, T, _ = p.shape
    qkv = jax.nn.silu(causal_depthwise_conv(p[..., :3 * GDN_DIM], conv_w))
    z = p[..., 3 * GDN_DIM:4 * GDN_DIM]
    b_raw = p[..., 4 * GDN_DIM:4 * GDN_DIM + GDN_HEADS].astype(jnp.float32)
    a_raw = p[..., 4 * GDN_DIM + GDN_HEADS:].astype(jnp.float32)
    qkv = qkv.astype(jnp.float32)
    q = qkv[..., :GDN_DIM].reshape(Bsz, T, GDN_HEADS, GDN_DK)
    k = qkv[..., GDN_DIM:2 * GDN_DIM].reshape(Bsz, T, GDN_HEADS, GDN_DK)
    v = qkv[..., 2 * GDN_DIM:].reshape(Bsz, T, GDN_HEADS, GDN_DV)
    beta = jax.nn.sigmoid(b_raw)
    g = -jnp.exp(a_log.astype(jnp.float32)) * jax.nn.softplus(a_raw + dt_bias.astype(jnp.float32))
    o = gated_delta_rule_chunked(q, k, v, g, beta)
    zf = z.astype(jnp.float32).reshape(Bsz, T, GDN_HEADS, GDN_DV)
    o = rmsnorm(o, norm_w) * jax.nn.silu(zf)
    return o.reshape(Bsz, T, GDN_DIM).astype(p.dtype)


def ssd_chunked(x, dt, A, Bm, Cm):
    Bsz, T, H, P = x.shape
    L = SSD_L = SSM_CHUNK
    Nc = T // L
    G, J, N = SSM_GROUPS, SSM_HPG, SSM_STATE
    xdt = (x * dt[..., None]).reshape(Bsz, Nc, L, G, J, P)
    a = (dt * A).reshape(Bsz, Nc, L, H).transpose(0, 3, 1, 2)
    Bc = Bm.reshape(Bsz, Nc, L, G, N)
    Cc = Cm.reshape(Bsz, Nc, L, G, N)
    a_cs = jnp.cumsum(a, axis=-1)
    causal = jnp.tril(jnp.ones((L, L), dtype=bool))
    seg = jnp.exp(jnp.where(causal, a_cs[..., :, None] - a_cs[..., None, :], -jnp.inf))
    CB = jnp.einsum('bclgn,bcsgn->bgcls', Cc, Bc)
    scores = seg.reshape(Bsz, G, J, Nc, L, L) * CB[:, :, None]
    y_diag = jnp.einsum('bgjcls,bcsgjp->bclgjp', scores, xdt)
    decay_states = jnp.exp(a_cs[..., -1:] - a_cs).reshape(Bsz, G, J, Nc, L)
    states = jnp.einsum('bclgn,bgjcl,bclgjp->bcgjpn', Bc, decay_states, xdt)
    chunk_decay = jnp.exp(a_cs[..., -1]).reshape(Bsz, G, J, Nc)

    def step(h, inp):
        st, dec = inp
        return h * dec[..., None, None] + st, h

    h0 = jnp.zeros((Bsz, G, J, P, N), jnp.float32)
    _, prev = lax.scan(step, h0, (jnp.moveaxis(states, 1, 0), jnp.moveaxis(chunk_decay, 3, 0)))
    prev = jnp.moveaxis(prev, 0, 1)
    y_off = jnp.einsum('bclgn,bcgjpn,bgjcl->bclgjp', Cc, prev,
                       jnp.exp(a_cs).reshape(Bsz, G, J, Nc, L))
    return (y_diag + y_off).reshape(Bsz, T, H, P)


def ssd_mixer(p, conv_w, conv_b, a_log, dt_bias, d_skip, norm_w):
    Bsz, T, _ = p.shape
    z = p[..., :SSM_DIM]
    xbc = jax.nn.silu(causal_depthwise_conv(p[..., SSM_DIM:2 * SSM_DIM + 2 * SSM_BC], conv_w, conv_b))
    dt_raw = p[..., 2 * SSM_DIM + 2 * SSM_BC:].astype(jnp.float32)
    xbc = xbc.astype(jnp.float32)
    xs = xbc[..., :SSM_DIM].reshape(Bsz, T, SSM_HEADS, SSM_HEADDIM)
    Bm = xbc[..., SSM_DIM:SSM_DIM + SSM_BC].reshape(Bsz, T, SSM_GROUPS, SSM_STATE)
    Cm = xbc[..., SSM_DIM + SSM_BC:].reshape(Bsz, T, SSM_GROUPS, SSM_STATE)
    dt = jax.nn.softplus(dt_raw + dt_bias.astype(jnp.float32))
    A = -jnp.exp(a_log.astype(jnp.float32))
    y = ssd_chunked(xs, dt, A, Bm, Cm) + xs * d_skip.astype(jnp.float32)[:, None]
    yg = (y.reshape(Bsz, T, SSM_DIM) * jax.nn.silu(z.astype(jnp.float32)))
    yg = yg.reshape(Bsz, T, SSM_GROUPS, SSM_DIM // SSM_GROUPS)
    yg = yg * lax.rsqrt(jnp.mean(yg * yg, axis=-1, keepdims=True) + EPS)
    yg = yg.reshape(Bsz, T, SSM_DIM) * norm_w.astype(jnp.float32)
    return yg.astype(p.dtype)


def memory_cross_attention(h, m, wq, wk, wv, wo):
    Bsz, T, _ = h.shape
    M = m.shape[1]
    q = (h @ wq).reshape(Bsz, T, MEM_HEADS, MEM_HEADDIM)
    k = (m @ wk).reshape(Bsz, M, MEM_HEADS, MEM_HEADDIM)
    v = (m @ wv).reshape(Bsz, M, MEM_HEADS, MEM_HEADDIM)
    s = jnp.einsum('bthd,bmhd->bhtm', q, k).astype(jnp.float32) * (MEM_HEADDIM ** -0.5)
    pr = jax.nn.softmax(s, axis=-1).astype(v.dtype)
    o = jnp.einsum('bhtm,bmhd->bthd', pr, v).reshape(Bsz, T, D_MODEL)
    return o @ wo


def _inv_softplus_dt(key, n):
    dt = jnp.exp(jax.random.uniform(key, (n,), minval=math.log(1e-3), maxval=math.log(1e-1)))
    return dt + jnp.log(-jnp.expm1(-dt))


def setup_inputs(seed: int = 0) -> dict:
    key = jax.random.key(seed)
    ks = jax.random.split(key, 26)
    nrm = lambda k, shape, s: jax.random.normal(k, shape, jnp.float32) * s
    gain = lambda k, n: 1.0 + 0.02 * jax.random.normal(k, (n,), jnp.float32)
    return {
        "x": nrm(ks[0], (BATCH, SEQ, D_MODEL), 1.0),
        "mem": nrm(ks[1], (BATCH, MEM_LEN, D_MODEL), 1.0),
        "norm1_w": gain(ks[2], D_MODEL),
        "w_in": nrm(ks[3], (D_MODEL, IN_COLS), D_MODEL ** -0.5),
        "gdn_conv_w": nrm(ks[4], (CONV_K, 3 * GDN_DIM), CONV_K ** -0.5),
        "gdn_a_log": jnp.log(jax.random.uniform(ks[5], (GDN_HEADS,), minval=1.0, maxval=16.0)),
        "gdn_dt_bias": _inv_softplus_dt(ks[6], GDN_HEADS),
        "gdn_norm_w": gain(ks[7], GDN_DV),
        "ssm_conv_w": nrm(ks[8], (CONV_K, SSM_DIM + 2 * SSM_BC), CONV_K ** -0.5),
        "ssm_conv_b": nrm(ks[9], (SSM_DIM + 2 * SSM_BC,), 0.02),
        "ssm_a_log": jnp.log(jax.random.uniform(ks[10], (SSM_HEADS,), minval=1.0, maxval=16.0)),
        "ssm_dt_bias": _inv_softplus_dt(ks[11], SSM_HEADS),
        "ssm_d": gain(ks[12], SSM_HEADS),
        "ssm_norm_w": gain(ks[13], SSM_DIM),
        "w_out": nrm(ks[14], (MIX_DIM, D_MODEL), MIX_DIM ** -0.5),
        "norm2_w": gain(ks[15], D_MODEL),
        "mem_norm_w": gain(ks[16], D_MODEL),
        "wq_mem": nrm(ks[17], (D_MODEL, D_MODEL), D_MODEL ** -0.5),
        "wk_mem": nrm(ks[18], (D_MODEL, D_MODEL), D_MODEL ** -0.5),
        "wv_mem": nrm(ks[19], (D_MODEL, D_MODEL), D_MODEL ** -0.5),
        "wo_mem": nrm(ks[20], (D_MODEL, D_MODEL), D_MODEL ** -0.5),
        "norm3_w": gain(ks[21], D_MODEL),
        "w_up": nrm(ks[22], (D_MODEL, D_FF), D_MODEL ** -0.5),
        "w_down": nrm(ks[23], (D_FF, D_MODEL), D_FF ** -0.5),
        "final_norm_w": gain(ks[24], D_MODEL),
    }


def reference(x, mem, norm1_w, w_in, gdn_conv_w, gdn_a_log, gdn_dt_bias, gdn_norm_w,
              ssm_conv_w, ssm_conv_b, ssm_a_log, ssm_dt_bias, ssm_d, ssm_norm_w, w_out,
              norm2_w, mem_norm_w, wq_mem, wk_mem, wv_mem, wo_mem, norm3_w, w_up, w_down,
              final_norm_w):
    m = rmsnorm(mem, mem_norm_w)
    for _ in range(DEPTH):
        h = rmsnorm(x, norm1_w)
        p = h @ w_in
        o_a = gdn_mixer(p[..., :GDN_COLS], gdn_conv_w, gdn_a_log, gdn_dt_bias, gdn_norm_w)
        o_b = ssd_mixer(p[..., GDN_COLS:], ssm_conv_w, ssm_conv_b, ssm_a_log, ssm_dt_bias,
                        ssm_d, ssm_norm_w)
        x = x + jnp.concatenate([o_a, o_b], axis=-1) @ w_out
        x = x + memory_cross_attention(rmsnorm(x, norm2_w), m, wq_mem, wk_mem, wv_mem, wo_mem)
        u = jax.nn.relu(rmsnorm(x, norm3_w) @ w_up)
        x = x + (u * u) @ w_down
    return rmsnorm(x, final_norm_w)
```

```cpp
#include <hip/hip_runtime.h>
#include <cstdio>
#include <cstdint>
namespace pg8 {
#define PG8_LAS __attribute__((address_space(3)))
typedef unsigned short bf16_t;
typedef short bf16x8 __attribute__((ext_vector_type(8)));
typedef float f32x4 __attribute__((ext_vector_type(4)));
typedef unsigned u32x4 __attribute__((ext_vector_type(4)));
constexpr int BM = 256, BK = 64, HALF = 128, HTB = HALF * BK * 2  , STAGE_BYTES = 8 * HTB, NXCD = 8, WGM = 8;

__host__ __device__ __forceinline__ int lds_byte(int r, int c) { const int st = (r >> 4) * 2 + (c >> 5), rr = r & 15, cc = c & 31, ob = rr * 64 + cc * 2; return st * 1024 + (ob ^ (((ob >> 9) & 1) << 5)); }
__host__ __device__ __forceinline__ void stage_rc(int b, int& R, int& C) { const int st = b / 1024, sb = b % 1024, swz = sb ^ (((sb >> 9) & 1) << 5); R = (st >> 1) * 16 + swz / 64; C = (st & 1) * 32 + (swz % 64) / 2; }
__host__ __device__ __forceinline__ int perm32(int rho) { const int n = rho >> 4, i = rho & 15; return 8 * (i >> 2) + 4 * n + (i & 3); }

struct Unit { int pm, pn; };
struct Gemm { const bf16_t* A; const bf16_t* Bt; int M, N, K; };

struct StaticOrder {
    int nM, nN, nwg, G, c;
    __host__ __device__ void init(int M, int N, int G_, int c_) { nM = M / BM; nN = N / BM; nwg = nM * nN; G = G_; c = c_; }
    __host__ __device__ bool next(int i, Unit& u) const {
        const long L = (long)i * G + c; if (L >= nwg) return false;
        int wgid = (int)L; { const int q = nwg / NXCD, r = nwg % NXCD, xcd = wgid % NXCD, off = wgid / NXCD; wgid = (xcd < r ? xcd * (q + 1) : r * (q + 1) + (xcd - r) * q) + off; }
        const int nig = WGM * nN, gid = wgid / nig, fm = gid * WGM, gsz = (nM - fm) < WGM ? (nM - fm) : WGM;
        u.pm = fm + ((wgid % nig) % gsz); u.pn = (wgid % nig) / gsz; return true;
    }
    __device__ __forceinline__ void a_ready(const Unit&) const {}
    __device__ __forceinline__ void done(const Unit&) const {}
};

typedef float f32x2_t __attribute__((ext_vector_type(2))); typedef __bf16 bf16x2_t __attribute__((ext_vector_type(2)));
__device__ __forceinline__ unsigned cvt_pk_bf16(float lo, float hi) { f32x2_t v = {lo, hi}; bf16x2_t b = __builtin_convertvector(v, bf16x2_t); return __builtin_bit_cast(unsigned, b); }

__device__ __forceinline__ u32x4 pack8(const f32x4 v0, const f32x4 v1) { u32x4 w; w.x = cvt_pk_bf16(v0[0], v0[1]); w.y = cvt_pk_bf16(v0[2], v0[3]); w.z = cvt_pk_bf16(v1[0], v1[1]); w.w = cvt_pk_bf16(v1[2], v1[3]); return w; }
__device__ __forceinline__ unsigned short bf1(float f) { return (unsigned short)(cvt_pk_bf16(f, 0.f) & 0xffffu); }

struct EpiIn {
    static constexpr bool PERM = true, AFTER_DRAIN = false;
    bf16_t* P; float* small; bf16_t* halo;
    __device__ __forceinline__ void operator()(const f32x4 (&acc)[2][2][4][2], const Unit& u, int wr, int wc, int fr, int fq) const {
        const int row0 = u.pm * BM + wr * 64 + fr;
        if (u.pn < 26) {
            const int col0 = u.pn * BM + wc * 32 + 8 * fq;
#pragma unroll
            for (int ai = 0; ai < 2; ++ai)
#pragma unroll
                for (int m = 0; m < 4; ++m) { const int row = row0 + ai * HALF + m * 16; bf16_t* rowp = P + (size_t)row * 6656 + col0;
#pragma unroll
                    for (int bj = 0; bj < 2; ++bj) { const u32x4 w = pack8(acc[ai][bj][m][0], acc[ai][bj][m][1]); *(u32x4*)(rowp + bj * HALF) = w;
                        if (m == 3) { if (u.pn < 12 && fr >= 13) *(u32x4*)(halo + ((size_t)(row >> 6) * 3 + (fr - 13)) * 3072 + col0 + bj * HALF) = w; } } }
        } else if (wc == 0) {
#pragma unroll
            for (int ai = 0; ai < 2; ++ai)
#pragma unroll
                for (int m = 0; m < 4; ++m) { const int row = row0 + ai * HALF + m * 16; float* sp = small + (size_t)row * 32 + 8 * fq;
                    *(f32x4*)sp = acc[ai][0][m][0]; *(f32x4*)(sp + 4) = acc[ai][0][m][1]; }
        }
    }
};
struct EpiKV {
    static constexpr bool PERM = true, AFTER_DRAIN = false;
    bf16_t* Km; bf16_t* VT;
    __device__ __forceinline__ void operator()(const f32x4 (&acc)[2][2][4][2], const Unit& u, int wr, int wc, int fr, int fq) const {
        const int row0 = u.pm * BM + wr * 64 + fr, col0 = u.pn * BM + wc * 32 + 8 * fq;
#pragma unroll
        for (int ai = 0; ai < 2; ++ai)
#pragma unroll
            for (int m = 0; m < 4; ++m) { const int row = row0 + ai * HALF + m * 16;
#pragma unroll
                for (int bj = 0; bj < 2; ++bj) { const int c = col0 + bj * HALF;
                    if (c < 1024) { *(u32x4*)(Km + (size_t)row * 1024 + c) = pack8(acc[ai][bj][m][0], acc[ai][bj][m][1]); }
                    else { const int cc = c - 1024, b = row >> 8, mm = row & 255;
#pragma unroll
                        for (int n = 0; n < 2; ++n)
#pragma unroll
                            for (int j = 0; j < 4; ++j) VT[((size_t)b * 1024 + cc + 4 * n + j) * 256 + mm] = bf1(acc[ai][bj][m][n][j]); } } }
    }
};
struct EpiRes {
    static constexpr bool PERM = true, AFTER_DRAIN = false;
    const float* base; float* out; bf16_t* outb; float* ssp;
    __device__ __forceinline__ void operator()(const f32x4 (&acc)[2][2][4][2], const Unit& u, int wr, int wc, int fr, int fq) const {
        const int row0 = u.pm * BM + wr * 64 + fr, col0 = u.pn * BM + wc * 32 + 8 * fq;
#pragma unroll
        for (int ai = 0; ai < 2; ++ai)
#pragma unroll
            for (int m = 0; m < 4; ++m) { const int row = row0 + ai * HALF + m * 16; float ss = 0.f;
#pragma unroll
                for (int bj = 0; bj < 2; ++bj) { const size_t off = (size_t)row * 1024 + col0 + bj * HALF;
                    const f32x4 v0 = *(const f32x4*)(base + off) + acc[ai][bj][m][0], v1 = *(const f32x4*)(base + off + 4) + acc[ai][bj][m][1];
                    *(f32x4*)(out + off) = v0; *(f32x4*)(out + off + 4) = v1;
                    if (outb) *(u32x4*)(outb + off) = pack8(v0, v1);
                    ss += (v0[0] * v0[0] + v0[1] * v0[1]) + (v0[2] * v0[2] + v0[3] * v0[3]) + (v1[0] * v1[0] + v1[1] * v1[1]) + (v1[2] * v1[2] + v1[3] * v1[3]); }
                ss += __shfl_xor(ss, 16); ss += __shfl_xor(ss, 32);
                if (ssp && fq == 0) ssp[(size_t)row * 16 + u.pn * 4 + wc] = ss; }
    }
};
template <int ACT> struct EpiScale {
    static constexpr bool PERM = true, AFTER_DRAIN = false;
    bf16_t* O; int ldc; const float* ssp; float scale;
    __device__ __forceinline__ void operator()(const f32x4 (&acc)[2][2][4][2], const Unit& u, int wr, int wc, int fr, int fq) const {
        const int row0 = u.pm * BM + wr * 64 + fr, col0 = u.pn * BM + wc * 32 + 8 * fq;
#pragma unroll
        for (int ai = 0; ai < 2; ++ai)
#pragma unroll
            for (int m = 0; m < 4; ++m) { const int row = row0 + ai * HALF + m * 16;
                const f32x4* sp = (const f32x4*)(ssp + (size_t)row * 16); const f32x4 s0 = sp[0], s1 = sp[1], s2 = sp[2], s3 = sp[3];
                const float tot = ((s0[0] + s0[1]) + (s0[2] + s0[3])) + ((s1[0] + s1[1]) + (s1[2] + s1[3])) + ((s2[0] + s2[1]) + (s2[2] + s2[3])) + ((s3[0] + s3[1]) + (s3[2] + s3[3]));
                const float rs = rsqrtf(tot * (1.0f / 1024.0f) + 1e-6f) * scale;
#pragma unroll
                for (int bj = 0; bj < 2; ++bj) { f32x4 v0 = acc[ai][bj][m][0] * rs, v1 = acc[ai][bj][m][1] * rs;
                    if (ACT == 1) {
#pragma unroll
                        for (int j = 0; j < 4; ++j) { const float a = fmaxf(v0[j], 0.f), b = fmaxf(v1[j], 0.f); v0[j] = a * a; v1[j] = b * b; } }
                    *(u32x4*)(O + (size_t)row * ldc + col0 + bj * HALF) = pack8(v0, v1); } }
    }
};

template <class Epi, class Sched, bool ALIGN_EPI = false, bool SP2 = false>
__device__ __forceinline__ void gemm_phase(PG8_LAS unsigned char* lds, const Gemm g, const Sched& S, const Epi& E) {
    const int tid = threadIdx.x, wid = __builtin_amdgcn_readfirstlane(tid >> 6), lane = tid & 63, wr = wid >> 2, wc = wid & 3, fr = lane & 15, fq = lane >> 4;
    const int K = g.K, nt = K / BK;
    unsigned voffA[2], voffB[2];
#pragma unroll
    for (int i = 0; i < 2; ++i) { int R, C; stage_rc(tid * 16 + i * 8192, R, C); const int Rb = Epi::PERM ? ((R & ~31) + perm32(R & 31)) : R;
        voffA[i] = (unsigned)(R * K + C) * 2u; voffB[i] = (unsigned)(Rb * K + C) * 2u; }
    const size_t kstep = (size_t)(BK * 2);
    const size_t hstep = (size_t)HALF * K * 2;
    const size_t tstep = 2 * hstep;
    const unsigned ldsw = (unsigned)wid * 1024u;
    const int aoff = lds_byte(wr * 64 + fr, fq * 8), boff = lds_byte(wc * 32 + fr, fq * 8);
#define PG8_SA(b, h) (((b) * 2 + (h)) * HTB)
#define PG8_SB(b, h) ((4 + (b) * 2 + (h)) * HTB)
#define PG8_STAGE(bufoff, gbase, voff) do { _Pragma("unroll") for (int _i = 0; _i < 2; ++_i) \
        __builtin_amdgcn_global_load_lds((const unsigned*)((const char*)(gbase) + (voff)[_i]), (PG8_LAS unsigned*)(lds + (bufoff) + ldsw + _i * 8192), 16, 0, 0); } while (0)
#define PG8_LDA(dst, b, h) do { _Pragma("unroll") for (int m = 0; m < 4; ++m) _Pragma("unroll") for (int k = 0; k < 2; ++k) dst[m][k] = *(const PG8_LAS bf16x8*)(lds + PG8_SA(b, h) + aoff + m * 2048 + k * 1024); } while (0)
#define PG8_LDB(dst, b, h) do { _Pragma("unroll") for (int n = 0; n < 2; ++n) _Pragma("unroll") for (int k = 0; k < 2; ++k) dst[n][k] = *(const PG8_LAS bf16x8*)(lds + PG8_SB(b, h) + boff + n * 2048 + k * 1024); } while (0)
#define PG8_MMA(ai, bj, At, Bt) do { __builtin_amdgcn_s_setprio(1); _Pragma("unroll") for (int m = 0; m < 4; ++m) _Pragma("unroll") for (int n = 0; n < 2; ++n) _Pragma("unroll") for (int k = 0; k < 2; ++k) \
        acc[ai][bj][m][n] = __builtin_amdgcn_mfma_f32_16x16x32_bf16(Bt[n][k], At[m][k], acc[ai][bj][m][n], 0, 0, 0); __builtin_amdgcn_s_setprio(0); } while (0)
#define PG8_WAIT_V(n) asm volatile("s_waitcnt vmcnt(" #n ")" ::: "memory")
#define PG8_WAIT_L(n) asm volatile("s_waitcnt lgkmcnt(" #n ")" ::: "memory")
#define PG8_BAR __builtin_amdgcn_s_barrier()
#define PG8_SCHED __builtin_amdgcn_sched_barrier(0)
    Unit cur, nxt; int ui = 0;
    if (!S.next(0, cur)) return;
    f32x4 acc[2][2][4][2];
#pragma unroll
    for (int a = 0; a < 2; ++a)
#pragma unroll
        for (int b = 0; b < 2; ++b)
#pragma unroll
            for (int m = 0; m < 4; ++m)
#pragma unroll
                for (int n = 0; n < 2; ++n) acc[a][b][m][n] = (f32x4){0.f, 0.f, 0.f, 0.f};
    bf16x8 At[4][2], B0[2][2], B1[2][2];
    const char* cA = (const char*)g.A + (size_t)cur.pm * tstep; const char* cB = (const char*)g.Bt + (size_t)cur.pn * tstep;
    S.a_ready(cur);
    if constexpr (SP2) {
        PG8_STAGE(PG8_SB(0, 0), cB, voffB); PG8_STAGE(PG8_SB(0, 1), cB + hstep, voffB); PG8_STAGE(PG8_SA(0, 0), cA, voffA); PG8_STAGE(PG8_SA(0, 1), cA + hstep, voffA);
        if (wr == 1) PG8_BAR;
        PG8_WAIT_V(2); PG8_BAR;
        PG8_STAGE(PG8_SB(1, 0), cB + kstep, voffB); PG8_STAGE(PG8_SA(1, 0), cA + kstep, voffA); PG8_STAGE(PG8_SB(1, 1), cB + hstep + kstep, voffB);
        PG8_WAIT_V(6); PG8_BAR;
    } else {
        PG8_STAGE(PG8_SB(0, 0), cB, voffB); PG8_STAGE(PG8_SA(0, 0), cA, voffA); PG8_STAGE(PG8_SB(0, 1), cB + hstep, voffB); PG8_STAGE(PG8_SA(0, 1), cA + hstep, voffA);
        if (wr == 1) PG8_BAR;
        PG8_WAIT_V(4); PG8_BAR;
        PG8_STAGE(PG8_SB(1, 0), cB + kstep, voffB); PG8_STAGE(PG8_SA(1, 0), cA + kstep, voffA); PG8_STAGE(PG8_SB(1, 1), cB + hstep + kstep, voffB);
        PG8_WAIT_V(6); PG8_BAR;
    }
    for (;;) {
        const bool has_next = S.next(ui + 1, nxt);
        const char* nA = has_next ? (const char*)g.A + (size_t)nxt.pm * tstep : cA; const char* nB = has_next ? (const char*)g.Bt + (size_t)nxt.pn * tstep : cB;
        for (int t = 0; t < nt; t += 2) {
            const bool last = (t == nt - 2);
            const char* a1 = cA + (size_t)(t + 1) * kstep;
            const char* a2 = last ? nA : cA + (size_t)(t + 2) * kstep; const char* b2 = last ? nB : cB + (size_t)(t + 2) * kstep;
            const char* a3 = a2 + kstep; const char* b3 = b2 + kstep;
            if (last && has_next) S.a_ready(nxt);
            if constexpr (SP2) {
            PG8_LDB(B0, 0, 0); PG8_LDB(B1, 0, 1); PG8_SCHED; PG8_LDA(At, 0, 0); PG8_STAGE(PG8_SA(1, 1), a1 + hstep, voffA);
            PG8_WAIT_V(8); PG8_WAIT_L(0); PG8_BAR; PG8_MMA(0, 0, At, B0); PG8_MMA(0, 1, At, B1); PG8_BAR; PG8_SCHED;
            PG8_LDA(At, 0, 1); PG8_STAGE(PG8_SB(0, 0), b2, voffB); PG8_STAGE(PG8_SB(0, 1), b2 + hstep, voffB); PG8_STAGE(PG8_SA(0, 0), a2, voffA);
            PG8_WAIT_V(8); PG8_WAIT_L(0); PG8_BAR; PG8_MMA(1, 0, At, B0); PG8_MMA(1, 1, At, B1); PG8_BAR; PG8_SCHED;
            PG8_LDB(B0, 1, 0); PG8_LDB(B1, 1, 1); PG8_SCHED; PG8_LDA(At, 1, 0); PG8_STAGE(PG8_SA(0, 1), a2 + hstep, voffA);
            PG8_WAIT_V(8); PG8_WAIT_L(0); PG8_BAR; PG8_MMA(0, 0, At, B0); PG8_MMA(0, 1, At, B1); PG8_BAR; PG8_SCHED;
            PG8_LDA(At, 1, 1); PG8_STAGE(PG8_SB(1, 0), b3, voffB); PG8_STAGE(PG8_SB(1, 1), b3 + hstep, voffB); PG8_STAGE(PG8_SA(1, 0), a3, voffA);
            PG8_WAIT_V(8); PG8_WAIT_L(0); PG8_BAR; PG8_MMA(1, 0, At, B0); PG8_MMA(1, 1, At, B1); PG8_BAR; PG8_SCHED;
            } else {
            PG8_LDB(B0, 0, 0); PG8_SCHED; PG8_LDA(At, 0, 0); PG8_STAGE(PG8_SA(1, 1), a1 + hstep, voffA);
            PG8_WAIT_L(8); PG8_BAR; PG8_WAIT_L(0); PG8_MMA(0, 0, At, B0); PG8_BAR; PG8_SCHED;
            PG8_LDB(B1, 0, 1); PG8_STAGE(PG8_SB(0, 0), b2, voffB);
            PG8_BAR; PG8_WAIT_L(0); PG8_MMA(0, 1, At, B1); PG8_BAR;
            PG8_LDA(At, 0, 1); PG8_STAGE(PG8_SA(0, 0), a2, voffA);
            PG8_BAR; PG8_WAIT_L(0); PG8_MMA(1, 0, At, B0); PG8_BAR; PG8_SCHED;
            PG8_STAGE(PG8_SB(0, 1), b2 + hstep, voffB);
            PG8_WAIT_V(6); PG8_BAR; PG8_MMA(1, 1, At, B1); PG8_BAR;
            PG8_LDB(B0, 1, 0); PG8_SCHED; PG8_LDA(At, 1, 0); PG8_STAGE(PG8_SA(0, 1), a2 + hstep, voffA);
            PG8_WAIT_L(8); PG8_BAR; PG8_WAIT_L(0); PG8_MMA(0, 0, At, B0); PG8_BAR; PG8_SCHED;
            PG8_LDB(B1, 1, 1); PG8_STAGE(PG8_SB(1, 0), b3, voffB);
            PG8_BAR; PG8_WAIT_L(0); PG8_MMA(0, 1, At, B1); PG8_BAR;
            PG8_LDA(At, 1, 1); PG8_STAGE(PG8_SA(1, 0), a3, voffA);
            PG8_BAR; PG8_WAIT_L(0); PG8_MMA(1, 0, At, B0); PG8_BAR; PG8_SCHED;
            PG8_STAGE(PG8_SB(1, 1), b3 + hstep, voffB);
            PG8_WAIT_V(6); PG8_BAR; PG8_MMA(1, 1, At, B1); PG8_BAR;
            }
        }
        if constexpr (ALIGN_EPI) { if (wr == 0) PG8_BAR; }
        if constexpr (!Epi::AFTER_DRAIN) { E(acc, cur, wr, wc, fr, fq); S.done(cur); }
        if (!has_next) break;
#pragma unroll
        for (int a = 0; a < 2; ++a)
#pragma unroll
            for (int b = 0; b < 2; ++b)
#pragma unroll
                for (int m = 0; m < 4; ++m)
#pragma unroll
                    for (int n = 0; n < 2; ++n) acc[a][b][m][n] = (f32x4){0.f, 0.f, 0.f, 0.f};
        cur = nxt; cA = nA; cB = nB; ++ui;
        if constexpr (ALIGN_EPI) { if (wr == 1) PG8_BAR; }
    }
    PG8_WAIT_V(0);
    if constexpr (!ALIGN_EPI) { if (wr == 0) PG8_BAR; }
    PG8_BAR;
    if constexpr (Epi::AFTER_DRAIN) { E.fused(acc, cur, wr, wc, fr, fq, lds, wid, lane); S.done(cur); }
#undef PG8_SA
#undef PG8_SB
#undef PG8_STAGE
#undef PG8_LDA
#undef PG8_LDB
#undef PG8_MMA
#undef PG8_WAIT_V
#undef PG8_WAIT_L
#undef PG8_BAR
#undef PG8_SCHED
}
}

constexpr int NWAVES = 8;
constexpr int BATCH = 2, T = 8192, D = 1024, M = BATCH * T, FF = 4096, MIXD = 2048, MEMLEN = 256;
constexpr int NP = 6656;
constexpr int NIN = 6912;
constexpr int PQ = 0, PK = 1024, PV = 2048, PZG = 3072, PZS = 4096, PXS = 5120, PB = 6144, PC = 6400;
constexpr float EPS = 1e-6f;
constexpr size_t MiB = 1u << 20;
constexpr size_t WS_CTL = 0, CTL_ZERO_BYTES = 64 * 1024;
constexpr size_t WS_CDV = 512 * 1024;
constexpr size_t WS_P = 1 * MiB;
constexpr size_t WS_WIN = 209 * MiB;
constexpr size_t WS_WKV = WS_WIN + 13 * MiB + 512 * 1024;
constexpr size_t WS_WOUT = WS_WKV + 4 * MiB;
constexpr size_t WS_WQ = WS_WOUT + 4 * MiB, WS_WO = WS_WQ + 2 * MiB, WS_WUP = WS_WO + 2 * MiB, WS_WDN = WS_WUP + 8 * MiB;
constexpr size_t WS_KMEM = WS_WDN + 8 * MiB;
constexpr size_t WS_VT = WS_KMEM + 1 * MiB;
constexpr size_t WS_MN = WS_VT + 1 * MiB;
constexpr size_t WS_SMALL = WS_MN + 1 * MiB;
constexpr size_t WS_END = WS_SMALL + 2 * MiB;
static_assert(WS_END <= 256 * MiB, "d_ws map");
constexpr size_t WS_CC = WS_WIN, WS_CB = WS_WIN + 8 * MiB;
static_assert(WS_CB + 8 * MiB <= WS_WOUT, "CB overlays w_in tail + wkv only");
constexpr size_t WS_X1 = 1 * MiB, WS_X1B = 65 * MiB, WS_Q = 97 * MiB, WS_AO = 129 * MiB, WS_HB = 97 * MiB;
static_assert(WS_HB + 128 * MiB <= WS_WOUT, "hb overlay");
constexpr size_t DO_XN1 = 0, DO_KDT = 0, DO_ATTN = 32 * MiB, DO_HALO = 48 * MiB, DO_BT = 52 * MiB + 512 * 1024;
constexpr int CW_BAR = 4096;
constexpr int RING_BYTES = 131072;
constexpr int LDS_BYTES = 147456;
constexpr int MISC_OFF = LDS_BYTES - 512;

#define GAS __attribute__((address_space(1)))
#define LAS __attribute__((address_space(3)))
typedef unsigned short bf16;
typedef unsigned u32x4 __attribute__((ext_vector_type(4)));
typedef unsigned u32x2 __attribute__((ext_vector_type(2)));
typedef float f32x4 __attribute__((ext_vector_type(4)));
typedef short bf16x8 __attribute__((ext_vector_type(8)));
typedef GAS unsigned gu32;
#define RLX_AGENT __ATOMIC_RELAXED, __HIP_MEMORY_SCOPE_AGENT
#define LDS_WAIT() asm volatile("s_waitcnt lgkmcnt(0)" ::: "memory")
#define VM_WAIT() asm volatile("s_waitcnt vmcnt(0)" ::: "memory")
__device__ __forceinline__ unsigned pk2(float lo, float hi) { return pg8::cvt_pk_bf16(lo, hi); }
__device__ __forceinline__ bf16 f2bf(float f) { return (bf16)(pk2(f, 0.f) & 0xffffu); }
__device__ __forceinline__ float bf2f(bf16 b) { return __uint_as_float((unsigned)b << 16); }
__device__ __forceinline__ float bflo(unsigned w) { return __uint_as_float(w << 16); }
__device__ __forceinline__ float bfhi(unsigned w) { return __uint_as_float(w & 0xffff0000u); }
__device__ __forceinline__ void unpack8(const u32x4 w, float* f) { f[0] = bflo(w.x); f[1] = bfhi(w.x); f[2] = bflo(w.y); f[3] = bfhi(w.y); f[4] = bflo(w.z); f[5] = bfhi(w.z); f[6] = bflo(w.w); f[7] = bfhi(w.w); }
__device__ __forceinline__ u32x4 pack8f(const float* f) { u32x4 w; w.x = pk2(f[0], f[1]); w.y = pk2(f[2], f[3]); w.z = pk2(f[4], f[5]); w.w = pk2(f[6], f[7]); return w; }
__device__ __forceinline__ u32x2 pack4(const f32x4 v) { u32x2 w; w.x = pk2(v[0], v[1]); w.y = pk2(v[2], v[3]); return w; }
__device__ __forceinline__ float silu_f(float y) { return y / (1.f + __expf(-y)); }
__device__ __forceinline__ float sigmoid_f(float y) { return 1.f / (1.f + __expf(-y)); }
__device__ __forceinline__ float softplus_f(float x) { return fmaxf(x, 0.f) + log1pf(__expf(-fabsf(x))); }
__device__ __forceinline__ f32x4 mfma16(bf16x8 a, bf16x8 b, f32x4 c) { return __builtin_amdgcn_mfma_f32_16x16x32_bf16(a, b, c, 0, 0, 0); }
__device__ __forceinline__ float wave_sum(float v) {
#pragma unroll
    for (int o = 1; o < 64; o <<= 1) v += __shfl_xor(v, o);
    return v;
}
__device__ __forceinline__ int opaque(int x) { asm volatile("" : "+v"(x)); return x; }
#define XB_TMO      128
#define XB_XCNT(j)  (256  + 64 * (j))
#define XB_XSUB(j)  (1280 + 64 * (j))
#define XB_XGEN(j)  (2304 + 64 * (j))
#define XB_TOP      3328
#define XB_TOPGEN   3392
#define XCD_BAR_WORDS 3456
#define XB_SPIN_CAP (1u << 18)

__device__ __forceinline__ unsigned xb_ld(unsigned* p)              { return __hip_atomic_load(p, __ATOMIC_RELAXED, __HIP_MEMORY_SCOPE_AGENT); }
__device__ __forceinline__ unsigned xb_add(unsigned* p, unsigned v) { return __hip_atomic_fetch_add(p, v, __ATOMIC_RELAXED, __HIP_MEMORY_SCOPE_AGENT); }
__device__ __forceinline__ unsigned xb_xcc_id() { return (unsigned)__builtin_amdgcn_s_getreg((3 << 11) | 20) & 0xFu; }
#define XB_SPIN(cond, bar) do { unsigned _sp = 0; while (cond) { __builtin_amdgcn_s_sleep(1); \
    if ((++_sp & 255u) == 0u) { if (xb_ld(&(bar)[XB_TMO])) break; if (_sp > XB_SPIN_CAP) { atomicAdd(&(bar)[XB_TMO], 1u); break; } } } } while (0)

struct XcdBarrier {
    unsigned* bar; unsigned x;
    volatile LAS unsigned* st;
};

__device__ __forceinline__ XcdBarrier xcd_barrier_post(unsigned* bar, volatile LAS unsigned* st) {
    XcdBarrier b; b.bar = bar; b.x = xb_xcc_id(); b.st = st;
    if (threadIdx.x == 0) (void)xb_add(&bar[XB_XCNT(b.x)], 1u);
    return b;
}
__device__ __forceinline__ void xcd_barrier_complete(unsigned* bar, unsigned x, unsigned& nloc, unsigned& nx) {
    const unsigned G = gridDim.x * gridDim.y * gridDim.z;
    unsigned sum, cnt, mine, sp = 0u;
    for (;;) {
        sum = 0u; cnt = 0u; mine = 0u;
#pragma unroll
        for (unsigned j = 0; j < 16; ++j) { const unsigned c = xb_ld(&bar[XB_XCNT(j)]); sum += c; cnt += (c > 0u) ? 1u : 0u; mine = (j == x) ? c : mine; }
        if (sum == G) break;
        __builtin_amdgcn_s_sleep(1);
        if ((++sp & 255u) == 0u) { if (xb_ld(&bar[XB_TMO])) break; if (sp > XB_SPIN_CAP) { atomicAdd(&bar[XB_TMO], 1u); break; } }
    }
    nloc = mine > 0u ? mine : 1u; nx = cnt > 0u ? cnt : 1u;
}

__device__ __forceinline__ void xcd_barrier(const XcdBarrier& b) {
    asm volatile("s_waitcnt vmcnt(0)" ::: "memory");
    __syncthreads();
    if (threadIdx.x == 0) {
        unsigned* bar = b.bar;
        __builtin_amdgcn_s_waitcnt(0);
        unsigned nloc = b.st[0], nx = b.st[1];
        if (nloc == 0u) { xcd_barrier_complete(bar, b.x, nloc, nx); b.st[0] = nloc; b.st[1] = nx; }
        const unsigned old = xb_add(&bar[XB_XSUB(b.x)], 1u);
        const unsigned gen = old / nloc;
        if (old + 1u == (gen + 1u) * nloc) {
            __builtin_amdgcn_fence(__ATOMIC_RELEASE, "agent");
            asm volatile("s_waitcnt vmcnt(0)" ::: "memory");
            const unsigned og = xb_add(&bar[XB_TOP], 1u);
            const unsigned tg = og / nx;
            if (og + 1u == (tg + 1u) * nx) xb_add(&bar[XB_TOPGEN], 1u);
            else XB_SPIN(xb_ld(&bar[XB_TOPGEN]) == tg, bar);
            __builtin_amdgcn_fence(__ATOMIC_ACQUIRE, "agent");
            xb_add(&bar[XB_XGEN(b.x)], 1u);
            asm volatile("s_waitcnt vmcnt(0)" ::: "memory");
        } else {
            XB_SPIN(xb_ld(&bar[XB_XGEN(b.x)]) == gen, bar);
            __builtin_amdgcn_fence(__ATOMIC_ACQUIRE, "agent");
            asm volatile("s_waitcnt vmcnt(0)" ::: "memory");
        }
    }
    __syncthreads();
}

struct Ctx {
    LAS unsigned char* lds;
    int tid, lane, wave, vcu, G, bx;
    const float *x, *mem, *norm1_w, *w_in, *gdn_conv_w, *gdn_a_log, *gdn_dt_bias, *gdn_norm_w, *ssm_conv_w, *ssm_conv_b, *ssm_a_log, *ssm_dt_bias, *ssm_d, *ssm_norm_w,
                *w_out, *norm2_w, *mem_norm_w, *wq, *wk, *wv, *wo, *norm3_w, *w_up, *w_down, *final_norm_w;
    float* out;
    unsigned char* ws; unsigned char* dob;
    bf16 *P, *Win_t, *Wkv_t, *Wout_t, *Wq_t, *Wo_t, *Wup_t, *Wdn_t, *Kmem, *VT, *MN, *XN1, *halo, *kdT, *attn, *BT, *Cc, *CB, *mix, *x1b, *qb, *ao, *hb;
    float *small, *cdv, *ssm_ss, *ssp, *x1;
};

template <class SrcCol>
__device__ __forceinline__ void p0_item(const float* W, int K, int Nsrc, bf16* WT, int nblk, LAS float* scr, int item, int lane, const float* kscale, SrcCol srccol) {
    const int kb = item / nblk, nb = item % nblk, k0 = 64 * kb, n0 = 32 * nb;
    const int sc = srccol(n0 + (lane & 31));
#pragma unroll 8
    for (int i = 0; i < 32; ++i) { const int kk = 2 * i + (lane >> 5); float v = sc >= 0 ? W[(size_t)(k0 + kk) * Nsrc + sc] : 0.f; if (kscale) v *= kscale[k0 + kk]; scr[kk * 33 + (lane & 31)] = v; }
    LDS_WAIT(); asm volatile("" ::: "memory");
    const int c = lane & 7;
#pragma unroll
    for (int j = 0; j < 4; ++j) { const int n = (lane >> 3) + 8 * j; const LAS float* s = scr + (8 * c) * 33 + n;
        u32x4 o; o.x = pk2(s[0 * 33], s[1 * 33]); o.y = pk2(s[2 * 33], s[3 * 33]); o.z = pk2(s[4 * 33], s[5 * 33]); o.w = pk2(s[6 * 33], s[7 * 33]);
        *(u32x4*)(WT + (size_t)(n0 + n) * K + k0 + 8 * c) = o; }
    LDS_WAIT(); asm volatile("" ::: "memory");
}
__device__ __forceinline__ void rms_row_to_bf16(const float* xrow, const float* w, bf16* orow, int lane) {
    const f32x4* xr = (const f32x4*)xrow + lane; const f32x4* wr = (const f32x4*)w + lane;
    f32x4 v[4]; float s = 0.f;
#pragma unroll
    for (int j = 0; j < 4; ++j) { v[j] = xr[64 * j]; s += (v[j][0] * v[j][0] + v[j][1] * v[j][1]) + (v[j][2] * v[j][2] + v[j][3] * v[j][3]); }
    const float rstd = rsqrtf(wave_sum(s) * (1.f / 1024.f) + EPS);
    u32x2* o8 = (u32x2*)orow + lane;
#pragma unroll
    for (int j = 0; j < 4; ++j) { const f32x4 o = v[j] * rstd * wr[64 * j]; o8[64 * j] = pack4(o); }
}
__device__ __forceinline__ void p0_prologue(const Ctx& C) {
    LAS float* scr = (LAS float*)(C.lds + C.wave * 16384);
    const int gw = C.vcu * NWAVES + C.wave, NGW = C.G * NWAVES, lane = C.lane;
    constexpr int I_IN = 16 * 216, I_KV = 16 * 32, I_OUT = 32 * 32, I_Q = 16 * 32, I_UP = 16 * 128, I_DN = 64 * 32;
    constexpr int NITEMS = I_IN + 2 * I_KV + I_OUT + 2 * I_Q + I_UP + I_DN;
    for (int it = gw; it < NITEMS; it += NGW) {
        int r = it;
        if (r < I_IN) { p0_item(C.w_in, 1024, 6688, C.Win_t, 216, scr, r, lane, nullptr,
                                [](int n) { return n < 4096 ? n : (n < 6656 ? n + 16 : (n < 6672 ? n - 2560 : (n < 6688 ? n : -1))); }); continue; } r -= I_IN;
        if (r < I_KV) { p0_item(C.wk, 1024, 1024, C.Wkv_t, 32, scr, r, lane, nullptr, [](int n) { return n; }); continue; } r -= I_KV;
        if (r < I_KV) { p0_item(C.wv, 1024, 1024, C.Wkv_t + (size_t)1024 * 1024, 32, scr, r, lane, nullptr, [](int n) { return n; }); continue; } r -= I_KV;
        if (r < I_OUT) { p0_item(C.w_out, 2048, 1024, C.Wout_t, 32, scr, r, lane, nullptr, [](int n) { return n; }); continue; } r -= I_OUT;
        if (r < I_Q) { p0_item(C.wq, 1024, 1024, C.Wq_t, 32, scr, r, lane, C.norm2_w, [](int n) { return n; }); continue; } r -= I_Q;
        if (r < I_Q) { p0_item(C.wo, 1024, 1024, C.Wo_t, 32, scr, r, lane, nullptr, [](int n) { return n; }); continue; } r -= I_Q;
        if (r < I_UP) { p0_item(C.w_up, 1024, 4096, C.Wup_t, 128, scr, r, lane, C.norm3_w, [](int n) { return n; }); continue; } r -= I_UP;
        p0_item(C.w_down, 4096, 1024, C.Wdn_t, 32, scr, r, lane, nullptr, [](int n) { return n; });
    }
    for (int m = gw; m < M; m += NGW) rms_row_to_bf16(C.x + (size_t)m * D, C.norm1_w, C.XN1 + (size_t)m * D, lane);
    for (int m = gw; m < BATCH * MEMLEN; m += NGW) rms_row_to_bf16(C.mem + (size_t)m * D, C.mem_norm_w, C.MN + (size_t)m * D, lane);
}

__device__ __forceinline__ void gdn_conv16(const Ctx& C, int t0, int gc, int c, int i, int col, float* outv) {
    float acc[16];
#pragma unroll
    for (int x = 0; x < 16; ++x) acc[x] = 0.f;
#pragma unroll
    for (int kk = 0; kk < 4; ++kk) {
        const int ri = i - 3 + kk;
        u32x4 a = (u32x4){0u, 0u, 0u, 0u}, b = a;
        if (ri >= 0) { const u32x4* s = (const u32x4*)(C.P + (size_t)(t0 + ri) * NP + col); a = s[0]; b = s[1]; }
        else if (c != 0) { const u32x4* s = (const u32x4*)(C.halo + ((size_t)(gc - 1) * 3 + (3 + ri)) * 3072 + col); a = s[0]; b = s[1]; }
        float xv[16]; unpack8(a, xv); unpack8(b, xv + 8);
        const f32x4* wp = (const f32x4*)(C.gdn_conv_w + (size_t)kk * 3072 + col);
#pragma unroll
        for (int j = 0; j < 4; ++j) { const f32x4 w = wp[j];
#pragma unroll
            for (int e = 0; e < 4; ++e) acc[4 * j + e] += w[e] * xv[4 * j + e]; }
    }
#pragma unroll
    for (int x = 0; x < 16; ++x) outv[x] = silu_f(acc[x]);
}
__device__ __forceinline__ void gdn_prep_unit(const Ctx& C, int un) {
    const int wv = C.wave;
#define GP_IDX() const int tid = opaque(C.tid), lane = tid & 63, r = lane & 15, q = lane >> 4; (void)r; (void)q; (void)lane;
    const int b = un >> 10, h = (un >> 7) & 7, c = un & 127;
    const int t0 = b * T + c * 64, gc = b * 128 + c;
    LAS bf16* QN = (LAS bf16*)(C.lds + 0);
    LAS bf16* KN = (LAS bf16*)(C.lds + 17408);
    LAS bf16* KB = (LAS bf16*)(C.lds + 34816);
    LAS bf16* VBT = (LAS bf16*)(C.lds + 52224);
    LAS bf16* KBGT = (LAS bf16*)(C.lds + 70656);
    LAS float* LM = (LAS float*)(C.lds + 89088);
    LAS bf16* TB = (LAS bf16*)(C.lds + 105728);
    LAS float* GCS = (LAS float*)(C.lds + 114944);
    LAS bf16* KDT = (LAS bf16*)(C.lds + 115200);
    float qv[16], kv[16];
    {
        GP_IDX(); const int i = tid >> 3, d0 = (tid & 7) * 16;
        const float beta = sigmoid_f(C.small[(size_t)(t0 + i) * 32 + h]);
        {
            gdn_conv16(C, t0, gc, c, i, PQ + h * 128 + d0, qv); asm volatile("" ::: "memory");
            float sq = 0.f;
#pragma unroll
            for (int x = 0; x < 16; ++x) sq += qv[x] * qv[x];
            sq += __shfl_xor(sq, 1); sq += __shfl_xor(sq, 2); sq += __shfl_xor(sq, 4);
            const float rq = rsqrtf(sq + EPS) * 0.08838834764831845f;
#pragma unroll
            for (int x = 0; x < 16; ++x) qv[x] *= rq;
            *(LAS u32x4*)(QN + i * 136 + d0) = pack8f(qv); *(LAS u32x4*)(QN + i * 136 + d0 + 8) = pack8f(qv + 8);
        }
        {
            gdn_conv16(C, t0, gc, c, i, PK + h * 128 + d0, kv); asm volatile("" ::: "memory");
            float sk = 0.f;
#pragma unroll
            for (int x = 0; x < 16; ++x) sk += kv[x] * kv[x];
            sk += __shfl_xor(sk, 1); sk += __shfl_xor(sk, 2); sk += __shfl_xor(sk, 4);
            const float rk = rsqrtf(sk + EPS);
            float t1[16];
#pragma unroll
            for (int x = 0; x < 16; ++x) { kv[x] *= rk; t1[x] = kv[x] * beta; }
            *(LAS u32x4*)(KN + i * 136 + d0) = pack8f(kv); *(LAS u32x4*)(KN + i * 136 + d0 + 8) = pack8f(kv + 8);
            *(LAS u32x4*)(KB + i * 136 + d0) = pack8f(t1); *(LAS u32x4*)(KB + i * 136 + d0 + 8) = pack8f(t1 + 8);
        }
        {
            float vv[16];
            gdn_conv16(C, t0, gc, c, i, PV + h * 128 + d0, vv); asm volatile("" ::: "memory");
            LAS bf16* vb = VBT + d0 * 72 + i;
#pragma unroll
            for (int x = 0; x < 16; ++x) vb[x * 72] = f2bf(vv[x] * beta);
        }
        if (tid < 64) {
            float g = -expf(C.gdn_a_log[h]) * softplus_f(C.small[(size_t)(t0 + tid) * 32 + 8 + h] + C.gdn_dt_bias[h]);
#pragma unroll
            for (int o = 1; o < 64; o <<= 1) { const float v2 = __shfl_up(g, o); if (lane >= o) g += v2; }
            GCS[tid] = g;
        }
    }
    __syncthreads();
    {
        GP_IDX(); const int i = tid >> 3, d0 = (tid & 7) * 16;
        const float gi = GCS[i], gl = GCS[63];
        const float eg = expf(gi), ek = expf(gl - gi);
        const float beta = sigmoid_f(C.small[(size_t)(t0 + i) * 32 + h]);
        {
            float t2[16];
#pragma unroll
            for (int x = 0; x < 16; ++x) t2[x] = qv[x] * eg;
            u32x4* qd = (u32x4*)(C.P + (size_t)(t0 + i) * NP + PQ + h * 128 + d0); qd[0] = pack8f(t2); qd[1] = pack8f(t2 + 8);
        }
        LAS bf16* kg = KBGT + d0 * 72 + i; LAS bf16* kd = KDT + d0 * 72 + i; const float bg = beta * eg;
#pragma unroll
        for (int x = 0; x < 16; ++x) { kg[x * 72] = f2bf(kv[x] * bg); kd[x * 72] = f2bf(kv[x] * ek); }
        if (tid == 0) C.cdv[un] = expf(gl);
    }
    __syncthreads();
    {
        GP_IDX();
        const int mt = wv & 3, which = wv >> 2;
        const LAS bf16* X = which ? QN : KB;
        bf16x8 xa[4];
#pragma unroll
        for (int ks = 0; ks < 4; ++ks) xa[ks] = *(const LAS bf16x8*)(X + (16 * mt + r) * 136 + 32 * ks + 8 * q);
#pragma unroll
        for (int nt = 0; nt < 4; ++nt) {
            bf16x8 kf[4];
#pragma unroll
            for (int ks = 0; ks < 4; ++ks) kf[ks] = *(const LAS bf16x8*)(KN + (16 * nt + r) * 136 + 32 * ks + 8 * q);
            f32x4 acc = (f32x4){0.f, 0.f, 0.f, 0.f};
            if (which == 0) {
#pragma unroll
                for (int ks = 0; ks < 4; ++ks) acc = mfma16(xa[ks], kf[ks], acc);
                const int jj = 16 * nt + r; const float gj = GCS[jj];
#pragma unroll
                for (int t = 0; t < 4; ++t) { const int ii = 16 * mt + 4 * q + t; LM[ii * 65 + jj] = (ii > jj) ? acc[t] * expf(GCS[ii] - gj) : 0.f; }
            } else {
#pragma unroll
                for (int ks = 0; ks < 4; ++ks) acc = mfma16(kf[ks], xa[ks], acc);
                const int ii = 16 * mt + r; const float gi = GCS[ii]; f32x4 o;
#pragma unroll
                for (int t = 0; t < 4; ++t) { const int jj = 16 * nt + 4 * q + t; o[t] = (ii >= jj) ? acc[t] * expf(gi - GCS[jj]) : 0.f; }
                *(u32x2*)(C.attn + ((size_t)un * 64 + ii) * 64 + 16 * nt + 4 * q) = pack4(o);
            }
        }
        for (int ch = tid; ch < 1024; ch += 512) { const int d = ch >> 3, part = ch & 7;
            *(u32x4*)(C.kdT + ((size_t)un * 128 + d) * 64 + part * 8) = *(const LAS u32x4*)(KDT + d * 72 + part * 8); }
    }
    __syncthreads();
    if (wv == 0) {
        GP_IDX();
        LM[lane] = (lane == 0) ? 1.f : 0.f;
        for (int ii = 1; ii < 64; ++ii) {
            const float lrow = LM[ii * 65 + lane];
            float a = (lane == ii) ? 1.f : 0.f;
            for (int j = 0; j < ii; ++j) { const float l = __builtin_bit_cast(float, __builtin_amdgcn_readlane(__builtin_bit_cast(int, lrow), j)); a -= l * LM[j * 65 + lane]; }
            LM[ii * 65 + lane] = a;
        }
    }
    __syncthreads();
    {
        GP_IDX(); const int i = tid >> 3;
        const int j0 = (tid & 7) * 8; float tv[8];
#pragma unroll
        for (int x = 0; x < 8; ++x) tv[x] = LM[i * 65 + j0 + x];
        *(LAS u32x4*)(TB + i * 72 + j0) = pack8f(tv);
    }
    __syncthreads();
    {
        GP_IDX();
        const int nt = wv;
        bf16x8 va[2], ka[2];
#pragma unroll
        for (int ks = 0; ks < 2; ++ks) { va[ks] = *(const LAS bf16x8*)(VBT + (16 * nt + r) * 72 + 32 * ks + 8 * q); ka[ks] = *(const LAS bf16x8*)(KBGT + (16 * nt + r) * 72 + 32 * ks + 8 * q); }
#pragma unroll
        for (int mt = 0; mt < 4; ++mt) {
            bf16x8 tf[2];
#pragma unroll
            for (int ks = 0; ks < 2; ++ks) tf[ks] = *(const LAS bf16x8*)(TB + (16 * mt + r) * 72 + 32 * ks + 8 * q);
            f32x4 au = (f32x4){0.f, 0.f, 0.f, 0.f}, aw = au;
            au = mfma16(va[0], tf[0], au); au = mfma16(va[1], tf[1], au);
            aw = mfma16(ka[0], tf[0], aw); aw = mfma16(ka[1], tf[1], aw);
            bf16* rowp = C.P + (size_t)(t0 + 16 * mt + r) * NP + h * 128 + 16 * nt + 4 * q;
            *(u32x2*)(rowp + PV) = pack4(au); *(u32x2*)(rowp + PK) = pack4(aw);
        }
    }
    __syncthreads();
#undef GP_IDX
}
__device__ __forceinline__ void ssd_prep_unit(const Ctx& C, int un2) {
    const int tid = C.tid, lane = C.lane, wv = C.wave, r = lane & 15, q = lane >> 4;
    const int b = un2 >> 7, c = (un2 >> 1) & 63, gg = un2 & 1;
    const int t0 = b * T + c * 128;
    LAS bf16* CS = (LAS bf16*)(C.lds + 0);
    LAS bf16* BS = (LAS bf16*)(C.lds + 34816);
    LAS bf16* BTS = (LAS bf16*)(C.lds + 69632);
    const int l = tid >> 2, n0 = (tid & 3) * 32;
#pragma unroll
    for (int tensor = 0; tensor < 2; ++tensor) {
        const int colP = (tensor ? PC : PB) + gg * 128 + n0, ch = 1024 + tensor * 256 + gg * 128 + n0;
        float acc[32];
#pragma unroll
        for (int j = 0; j < 8; ++j) { const f32x4 bv = *(const f32x4*)(C.ssm_conv_b + ch + 4 * j); acc[4 * j] = bv[0]; acc[4 * j + 1] = bv[1]; acc[4 * j + 2] = bv[2]; acc[4 * j + 3] = bv[3]; }
#pragma unroll
        for (int kk = 0; kk < 4; ++kk) {
            const int rl = c * 128 + l - 3 + kk;
            if (rl >= 0) {
                const u32x4* s = (const u32x4*)(C.P + (size_t)(b * T + rl) * NP + colP);
                const f32x4* wp = (const f32x4*)(C.ssm_conv_w + (size_t)kk * 1536 + ch);
#pragma unroll
                for (int j = 0; j < 4; ++j) { float xv[8]; unpack8(s[j], xv); const f32x4 w0 = wp[2 * j], w1 = wp[2 * j + 1];
#pragma unroll
                    for (int e = 0; e < 4; ++e) { acc[8 * j + e] += w0[e] * xv[e]; acc[8 * j + 4 + e] += w1[e] * xv[4 + e]; } }
            }
            asm volatile("" ::: "memory");
        }
#pragma unroll
        for (int x = 0; x < 32; ++x) acc[x] = silu_f(acc[x]);
        LAS bf16* dst = (tensor ? CS : BS) + l * 136 + n0;
#pragma unroll
        for (int j = 0; j < 4; ++j) { const u32x4 w = pack8f(acc + 8 * j); *(LAS u32x4*)(dst + 8 * j) = w;
            if (tensor) *(u32x4*)(C.Cc + (size_t)(t0 + l) * 256 + gg * 128 + n0 + 8 * j) = w; }
        if (!tensor) {
#pragma unroll
            for (int x = 0; x < 32; ++x) BTS[(n0 + x) * 136 + l] = f2bf(acc[x]);
        }
    }
    __syncthreads();
    {
        bf16x8 cf[4];
#pragma unroll
        for (int ks = 0; ks < 4; ++ks) cf[ks] = *(const LAS bf16x8*)(CS + (16 * wv + r) * 136 + 32 * ks + 8 * q);
#pragma unroll
        for (int st = 0; st < 8; ++st) {
            f32x4 acc = (f32x4){0.f, 0.f, 0.f, 0.f};
#pragma unroll
            for (int ks = 0; ks < 4; ++ks) { const bf16x8 bfr = *(const LAS bf16x8*)(BS + (16 * st + r) * 136 + 32 * ks + 8 * q); acc = mfma16(bfr, cf[ks], acc); }
            *(u32x2*)(C.CB + ((size_t)un2 * 128 + 16 * wv + r) * 128 + 16 * st + 4 * q) = pack4(acc);
        }
        for (int ch = tid; ch < 2048; ch += 512) { const int n = ch >> 4, part = ch & 15;
            *(u32x4*)(C.BT + ((size_t)un2 * 128 + n) * 128 + part * 8) = *(const LAS u32x4*)(BTS + n * 136 + part * 8); }
    }
    __syncthreads();
}

__device__ __forceinline__ void gdn_scan(const Ctx& C, int bh, int eb) {
    const int tid = C.tid, lane = C.lane, wv = C.wave, r = lane & 15, q = lane >> 4;
    const int b = bh >> 3, h = bh & 7, e0 = 16 * eb;
    LAS bf16* ST = (LAS bf16*)(C.lds + 0);
    LAS bf16* VNT = (LAS bf16*)(C.lds + 4352);
    for (int idx = tid; idx < (4352 + 2304) / 4; idx += 512) ((LAS unsigned*)C.lds)[idx] = 0u;
    f32x4 S = (f32x4){0.f, 0.f, 0.f, 0.f};
    __syncthreads();
    const int mt = wv & 3;
    for (int c = 0; c < 128; ++c) {
        const int un = bh * 128 + c; const size_t t0 = (size_t)b * T + (size_t)c * 64;
        const float cd = C.cdv[un];
        f32x4 acc = (f32x4){0.f, 0.f, 0.f, 0.f};
        {
            const bf16* arow = C.P + (t0 + 16 * mt + r) * NP + (wv < 4 ? PK : PQ) + h * 128 + 8 * q;
#pragma unroll
            for (int ks = 0; ks < 4; ++ks) { const bf16x8 af = *(const bf16x8*)(arow + 32 * ks); const bf16x8 sf = *(const LAS bf16x8*)(ST + r * 136 + 32 * ks + 8 * q); acc = mfma16(af, sf, acc); }
        }
        if (wv < 4) {
            f32x4 vn;
#pragma unroll
            for (int t = 0; t < 4; ++t) vn[t] = bf2f(C.P[(t0 + 16 * mt + 4 * q + t) * NP + PV + h * 128 + e0 + r]) - acc[t];
            *(LAS u32x2*)(VNT + r * 72 + 16 * mt + 4 * q) = pack4(vn);
        }
        __syncthreads();
        bf16x8 vf[2];
#pragma unroll
        for (int ks = 0; ks < 2; ++ks) vf[ks] = *(const LAS bf16x8*)(VNT + r * 72 + 32 * ks + 8 * q);
        if (wv >= 4) {
#pragma unroll
            for (int ks = 0; ks < 2; ++ks) { const bf16x8 af = *(const bf16x8*)(C.attn + ((size_t)un * 64 + 16 * mt + r) * 64 + 32 * ks + 8 * q); acc = mfma16(af, vf[ks], acc); }
#pragma unroll
            for (int t = 0; t < 4; ++t) C.P[(t0 + 16 * mt + 4 * q + t) * NP + PV + h * 128 + e0 + r] = f2bf(acc[t]);
        }
        S = S * cd;
#pragma unroll
        for (int ks = 0; ks < 2; ++ks) { const bf16x8 kf = *(const bf16x8*)(C.kdT + ((size_t)un * 128 + 16 * wv + r) * 64 + 32 * ks + 8 * q); S = mfma16(kf, vf[ks], S); }
        *(LAS u32x2*)(ST + r * 136 + 16 * wv + 4 * q) = pack4(S);
        __syncthreads();
    }
}
__device__ __forceinline__ void ssd_scan(const Ctx& C, int b, int hh) {
    const int tid = C.tid, lane = C.lane, wv = C.wave, r = lane & 15, q = lane >> 4;
    const int gg = hh >> 3;
    LAS bf16* XDT = (LAS bf16*)(C.lds + 0);
    LAS bf16* XDS = (LAS bf16*)(C.lds + 17408);
    LAS bf16* HP = (LAS bf16*)(C.lds + 34816);
    LAS bf16* XSK = (LAS bf16*)(C.lds + 52224);
    LAS float* ACS = (LAS float*)(C.lds + 70656);
    LAS float* DTV = (LAS float*)(C.lds + 71168);
    LAS bf16* XH = (LAS bf16*)(C.lds + 71680);
    for (int idx = tid; idx < 17408 / 4; idx += 512) ((LAS unsigned*)(C.lds + 34816))[idx] = 0u;
    for (int idx = tid; idx < 384 / 4; idx += 512) ((LAS unsigned*)(C.lds + 71680))[idx] = 0u;
    f32x4 H[4];
#pragma unroll
    for (int pt = 0; pt < 4; ++pt) H[pt] = (f32x4){0.f, 0.f, 0.f, 0.f};
    const float Aneg = -expf(C.ssm_a_log[hh]), dtb = C.ssm_dt_bias[hh], Dsk = C.ssm_d[hh];
    __syncthreads();
    const int l = tid >> 2, p0 = (tid & 3) * 16, colP = PXS + hh * 64 + p0, chn = hh * 64 + p0;
    for (int c = 0; c < 64; ++c) {
        const size_t t0 = (size_t)b * T + (size_t)c * 128; const size_t un2 = ((size_t)b * 64 + c) * 2 + gg;
        float xs[16]; u32x4 raw0 = (u32x4){0u, 0u, 0u, 0u}, raw1 = raw0;
        {
            float acc[16];
#pragma unroll
            for (int j = 0; j < 4; ++j) { const f32x4 bv = *(const f32x4*)(C.ssm_conv_b + chn + 4 * j); acc[4 * j] = bv[0]; acc[4 * j + 1] = bv[1]; acc[4 * j + 2] = bv[2]; acc[4 * j + 3] = bv[3]; }
#pragma unroll
            for (int kk = 0; kk < 4; ++kk) {
                const int rl = l - 3 + kk; u32x4 a, bb;
                if (rl >= 0) { const u32x4* s = (const u32x4*)(C.P + (t0 + rl) * NP + colP); a = s[0]; bb = s[1]; }
                else { const LAS u32x4* s = (const LAS u32x4*)(XH + (3 + rl) * 64 + p0); a = s[0]; bb = s[1]; }
                if (kk == 3) { raw0 = a; raw1 = bb; }
                float xv[16]; unpack8(a, xv); unpack8(bb, xv + 8);
                const f32x4* wp = (const f32x4*)(C.ssm_conv_w + (size_t)kk * 1536 + chn);
#pragma unroll
                for (int j = 0; j < 4; ++j) { const f32x4 w = wp[j];
#pragma unroll
                    for (int e = 0; e < 4; ++e) acc[4 * j + e] += w[e] * xv[4 * j + e]; }
            }
#pragma unroll
            for (int x = 0; x < 16; ++x) xs[x] = silu_f(acc[x]);
        }
        if (tid < 64) {
            const int r0 = 2 * tid;
            const float dt0 = softplus_f(C.small[(t0 + r0) * 32 + 16 + hh] + dtb), dt1 = softplus_f(C.small[(t0 + r0 + 1) * 32 + 16 + hh] + dtb);
            const float a0 = dt0 * Aneg, a1 = dt1 * Aneg; float s = a0 + a1; const float own = s;
#pragma unroll
            for (int o = 1; o < 64; o <<= 1) { const float v2 = __shfl_up(s, o); if (lane >= o) s += v2; }
            const float excl = s - own;
            ACS[r0] = excl + a0; ACS[r0 + 1] = excl + a0 + a1; DTV[r0] = dt0; DTV[r0 + 1] = dt1;
        }
        __syncthreads();
        {
            const float dtl = DTV[l], al = ACS[l], alast = ACS[127], ed = expf(alast - al);
            float tk[16];
#pragma unroll
            for (int x = 0; x < 16; ++x) { const float xd = xs[x] * dtl; XDT[(p0 + x) * 136 + l] = f2bf(xd); XDS[(p0 + x) * 136 + l] = f2bf(xd * ed); tk[x] = xs[x] * Dsk; }
            *(LAS u32x4*)(XSK + l * 72 + p0) = pack8f(tk); *(LAS u32x4*)(XSK + l * 72 + p0 + 8) = pack8f(tk + 8);
            if (l >= 125) { *(LAS u32x4*)(XH + (l - 125) * 64 + p0) = raw0; *(LAS u32x4*)(XH + (l - 125) * 64 + p0 + 8) = raw1; }
        }
        __syncthreads();
        f32x4 Hn[4];
        {
            const int lrow = 16 * wv + r; const float al_r = ACS[lrow], alast = ACS[127];
            f32x4 yd[4], yo[4];
#pragma unroll
            for (int pt = 0; pt < 4; ++pt) { yd[pt] = (f32x4){0.f, 0.f, 0.f, 0.f}; yo[pt] = yd[pt]; Hn[pt] = yd[pt]; }
#pragma unroll
            for (int ks = 0; ks < 4; ++ks) {
                const u32x4 cbw = *(const u32x4*)(C.CB + (un2 * 128 + lrow) * 128 + 32 * ks + 8 * q);
                float cbv[8]; unpack8(cbw, cbv);
                const f32x4 a0 = *(const LAS f32x4*)(ACS + 32 * ks + 8 * q), a1 = *(const LAS f32x4*)(ACS + 32 * ks + 8 * q + 4);
#pragma unroll
                for (int x = 0; x < 8; ++x) { const int s = 32 * ks + 8 * q + x; const float as = x < 4 ? a0[x & 3] : a1[x & 3]; cbv[x] = (s <= lrow) ? cbv[x] * expf(al_r - as) : 0.f; }
                const bf16x8 sfrag = __builtin_bit_cast(bf16x8, pack8f(cbv));
                const bf16x8 cfrag = *(const bf16x8*)(C.Cc + (t0 + lrow) * 256 + gg * 128 + 32 * ks + 8 * q);
                const bf16x8 bfr = *(const bf16x8*)(C.BT + (un2 * 128 + 16 * wv + r) * 128 + 32 * ks + 8 * q);
#pragma unroll
                for (int pt = 0; pt < 4; ++pt) {
                    const bf16x8 xa = *(const LAS bf16x8*)(XDT + (16 * pt + r) * 136 + 32 * ks + 8 * q);
                    const bf16x8 ha = *(const LAS bf16x8*)(HP + (16 * pt + r) * 136 + 32 * ks + 8 * q);
                    const bf16x8 xd = *(const LAS bf16x8*)(XDS + (16 * pt + r) * 136 + 32 * ks + 8 * q);
                    yd[pt] = mfma16(xa, sfrag, yd[pt]);
                    yo[pt] = mfma16(ha, cfrag, yo[pt]);
                    Hn[pt] = mfma16(bfr, xd, Hn[pt]);
                }
            }
            const float eal = expf(al_r); float ss = 0.f;
#pragma unroll
            for (int pt = 0; pt < 4; ++pt) {
                const u32x2 xk = *(const LAS u32x2*)(XSK + lrow * 72 + 16 * pt + 4 * q);
                const u32x2 zz = *(const u32x2*)(C.P + (t0 + lrow) * NP + PZS + hh * 64 + 16 * pt + 4 * q);
                const float xk4[4] = {bflo(xk.x), bfhi(xk.x), bflo(xk.y), bfhi(xk.y)}, z4[4] = {bflo(zz.x), bfhi(zz.x), bflo(zz.y), bfhi(zz.y)};
                f32x4 o;
#pragma unroll
                for (int t = 0; t < 4; ++t) { const float y = yd[pt][t] + eal * yo[pt][t] + xk4[t]; const float yg = y * silu_f(z4[t]); ss += yg * yg; o[t] = yg; }
                *(u32x2*)(C.P + (t0 + lrow) * NP + PXS + hh * 64 + 16 * pt + 4 * q) = pack4(o);
            }
            ss += __shfl_xor(ss, 16); ss += __shfl_xor(ss, 32);
            if (q == 0) C.ssm_ss[(t0 + lrow) * 16 + hh] = ss;
            const float cdec = expf(alast);
#pragma unroll
            for (int pt = 0; pt < 4; ++pt) H[pt] = H[pt] * cdec + Hn[pt];
        }
        __syncthreads();
#pragma unroll
        for (int pt = 0; pt < 4; ++pt) *(LAS u32x2*)(HP + (16 * pt + r) * 136 + 16 * wv + 4 * q) = pack4(H[pt]);
    }
    __syncthreads();
}

__device__ __forceinline__ void p4_finish(const Ctx& C) {
    const int gw = C.vcu * NWAVES + C.wave, NGW = C.G * NWAVES, lane = C.lane, c0 = 16 * lane;
    for (int m = gw; m < M; m += NGW) {
        const bf16* prow = C.P + (size_t)m * NP;
        {
            float o[16], z[16]; const u32x4* op = (const u32x4*)(prow + PV + c0); const u32x4* zp = (const u32x4*)(prow + PZG + c0);
            unpack8(op[0], o); unpack8(op[1], o + 8); unpack8(zp[0], z); unpack8(zp[1], z + 8);
            float ss = 0.f;
#pragma unroll
            for (int x = 0; x < 16; ++x) ss += o[x] * o[x];
            ss += __shfl_xor(ss, 1); ss += __shfl_xor(ss, 2); ss += __shfl_xor(ss, 4);
            const float rs = rsqrtf(ss * (1.f / 128.f) + EPS);
            const f32x4* nw = (const f32x4*)(C.gdn_norm_w + (c0 & 127));
#pragma unroll
            for (int j = 0; j < 4; ++j) { const f32x4 w = nw[j];
#pragma unroll
                for (int e = 0; e < 4; ++e) o[4 * j + e] = o[4 * j + e] * rs * w[e] * silu_f(z[4 * j + e]); }
            u32x4* mp = (u32x4*)(C.mix + (size_t)m * MIXD + c0); mp[0] = pack8f(o); mp[1] = pack8f(o + 8);
        }
        {
            const int g = lane >> 5; const f32x4* sp = (const f32x4*)(C.ssm_ss + (size_t)m * 16 + 8 * g); const f32x4 s0 = sp[0], s1 = sp[1];
            const float tot = ((s0[0] + s0[1]) + (s0[2] + s0[3])) + ((s1[0] + s1[1]) + (s1[2] + s1[3]));
            const float rs = rsqrtf(tot * (1.f / 512.f) + EPS);
            float y[16]; const u32x4* yp = (const u32x4*)(prow + PXS + c0); unpack8(yp[0], y); unpack8(yp[1], y + 8);
            const f32x4* nw = (const f32x4*)(C.ssm_norm_w + c0);
#pragma unroll
            for (int j = 0; j < 4; ++j) { const f32x4 w = nw[j];
#pragma unroll
                for (int e = 0; e < 4; ++e) y[4 * j + e] = y[4 * j + e] * rs * w[e]; }
            u32x4* mp = (u32x4*)(C.mix + (size_t)m * MIXD + 1024 + c0); mp[0] = pack8f(y); mp[1] = pack8f(y + 8);
        }
    }
}

__device__ __forceinline__ void attn_unit(const Ctx& C, int un) {
    const int wv = C.wave;
    const int pm = un >> 2, hd = un & 3, b = pm >> 5;
    const size_t tq0 = (size_t)pm * 256 + 32 * wv;
    LAS bf16* PS = (LAS bf16*)(C.lds + wv * 16896);
    const char* Kb = (const char*)(C.Kmem + (size_t)b * 256 * 1024 + hd * 256);
    const char* Vb = (const char*)(C.VT + ((size_t)b * 1024 + hd * 256) * 256);
    const char* Qb = (const char*)(C.qb + tq0 * 1024 + hd * 256);
    char* Ob = (char*)(C.ao + tq0 * 1024 + hd * 256);
#pragma unroll 1
    for (int it = 0; it < 2; ++it) {
        const int lane = opaque(C.lane), r = lane & 15, q = lane >> 4;
        bf16x8 qf[8];
        const unsigned qoff = (unsigned)((16 * it + r) * 1024 + 8 * q) * 2u;
#pragma unroll
        for (int ks = 0; ks < 8; ++ks) qf[ks] = *(const bf16x8*)(Qb + qoff + 64 * ks);
        const unsigned koff = (unsigned)(r * 1024 + 8 * q) * 2u;
        f32x4 sc[16];
#pragma unroll
        for (int mt = 0; mt < 16; ++mt) {
            f32x4 acc = (f32x4){0.f, 0.f, 0.f, 0.f};
#pragma unroll
            for (int ks = 0; ks < 8; ++ks) acc = mfma16(*(const bf16x8*)(Kb + (koff + (unsigned)(mt * 32768 + 64 * ks))), qf[ks], acc);
            sc[mt] = acc;
            if (mt & 1) asm volatile("" ::: "memory");
        }
        float mx = -3.0e38f;
#pragma unroll
        for (int mt = 0; mt < 16; ++mt) mx = fmaxf(fmaxf(fmaxf(sc[mt][0], sc[mt][1]), fmaxf(sc[mt][2], sc[mt][3])), mx);
        mx = fmaxf(mx, __shfl_xor(mx, 16)); mx = fmaxf(mx, __shfl_xor(mx, 32));
        float sum = 0.f;
#pragma unroll
        for (int mt = 0; mt < 16; ++mt)
#pragma unroll
            for (int t = 0; t < 4; ++t) { const float e = __expf(sc[mt][t] - mx); sc[mt][t] = e; sum += e; }
        sum += __shfl_xor(sum, 16); sum += __shfl_xor(sum, 32);
        const float inv = 1.f / sum;
        LAS bf16* prow = PS + (16 * it + r) * 264 + 4 * q;
#pragma unroll
        for (int mt = 0; mt < 16; ++mt) *(LAS u32x2*)(prow + 16 * mt) = pack4(sc[mt] * inv);
    }
    LDS_WAIT(); asm volatile("" ::: "memory");
#pragma unroll 1
    for (int it = 0; it < 2; ++it) {
        const int lane = opaque(C.lane), r = lane & 15, q = lane >> 4;
        bf16x8 pf[8];
        const LAS bf16* prow = PS + (16 * it + r) * 264 + 8 * q;
#pragma unroll
        for (int ks = 0; ks < 8; ++ks) pf[ks] = *(const LAS bf16x8*)(prow + 32 * ks);
        const unsigned voff = (unsigned)(r * 256 + 8 * q) * 2u;
        const unsigned ooff = (unsigned)((16 * it + r) * 1024 + 4 * q) * 2u;
#pragma unroll
        for (int dt = 0; dt < 16; ++dt) {
            f32x4 acc = (f32x4){0.f, 0.f, 0.f, 0.f};
#pragma unroll
            for (int ks = 0; ks < 8; ++ks) acc = mfma16(*(const bf16x8*)(Vb + (voff + (unsigned)(dt * 8192 + 64 * ks))), pf[ks], acc);
            *(u32x2*)(Ob + (ooff + (unsigned)(dt * 32))) = pack4(acc);
            if (dt & 1) asm volatile("" ::: "memory");
        }
    }
}

__device__ __forceinline__ void p11_final(const Ctx& C) {
    const int gw = C.vcu * NWAVES + C.wave, NGW = C.G * NWAVES, lane = C.lane;
    for (int m = gw; m < M; m += NGW) {
        f32x4* xr = (f32x4*)(C.out + (size_t)m * D) + lane; const f32x4* wr = (const f32x4*)C.final_norm_w + lane;
        f32x4 v[4]; float s = 0.f;
#pragma unroll
        for (int j = 0; j < 4; ++j) { v[j] = xr[64 * j]; s += (v[j][0] * v[j][0] + v[j][1] * v[j][1]) + (v[j][2] * v[j][2] + v[j][3] * v[j][3]); }
        const float rstd = rsqrtf(wave_sum(s) * (1.f / 1024.f) + EPS);
#pragma unroll
        for (int j = 0; j < 4; ++j) xr[64 * j] = v[j] * rstd * wr[64 * j];
    }
}


#ifdef DBG_CK
__device__ __forceinline__ float ck_sum(const bf16* p, size_t n16, int gw, int NGW, int lane) {
    float s = 0.f;
    for (size_t i = (size_t)gw * 64 + lane; i < n16; i += (size_t)NGW * 64) { float v[8]; unpack8(((const u32x4*)p)[i], v);
#pragma unroll
        for (int x = 0; x < 8; ++x) s += fabsf(v[x]) < 1e30f ? fabsf(v[x]) : 777.f; }
    return wave_sum(s);
}
__device__ __forceinline__ void dbg_ck_a(const Ctx& C) {
    const int gw = C.vcu * NWAVES + C.wave, NGW = C.G * NWAVES, lane = C.lane;
    float* ck = (float*)(C.ws + 255 * MiB + 512 * 1024);
    float r[8];
    r[0] = ck_sum(C.attn, (size_t)16 * MiB / 16, gw, NGW, lane);
    r[1] = ck_sum(C.kdT, (size_t)32 * MiB / 16, gw, NGW, lane);
    r[2] = ck_sum(C.BT, (size_t)8 * MiB / 16, gw, NGW, lane);
    r[3] = ck_sum(C.Cc, (size_t)8 * MiB / 16, gw, NGW, lane);
    r[4] = ck_sum(C.CB, (size_t)8 * MiB / 16, gw, NGW, lane);
    r[5] = C.cdv[gw]; r[6] = 0.f; r[7] = 0.f;
    if (lane < 8) { float v = 0.f;
#pragma unroll
        for (int x = 0; x < 8; ++x) if (lane == x) v = ((DBG_CK >> x) & 1) ? r[x] : 0.f;
        ck[gw * 8 + lane] = v; }
}
__device__ __forceinline__ void dbg_ck_b(const Ctx& C) {
    const float* ck = (const float*)(C.ws + 255 * MiB + 512 * 1024);
    for (size_t i = (size_t)C.bx * 512 + C.tid; i < (size_t)M * D; i += (size_t)C.G * 512) C.out[i] = ck[i & 16383];
}
#endif
#ifdef DBG_PHASE
__device__ __forceinline__ void dbg_digest(const Ctx& C) {
    const int gw = C.vcu * NWAVES + C.wave, NGW = C.G * NWAVES, lane = C.lane;
    for (int m = gw; m < M; m += NGW) {
        float acc[16];
#pragma unroll
        for (int x = 0; x < 16; ++x) acc[x] = 0.f;
        const int c0 = 16 * lane;
        if (DBG_PHASE <= 3) {
            const bf16* prow = C.P + (size_t)m * NP;
#pragma unroll
            for (int sct = 0; sct < 6; ++sct) { if (!((DBG_SEL >> sct) & 1)) continue; float v[16]; const u32x4* p = (const u32x4*)(prow + sct * 1024 + c0); unpack8(p[0], v); unpack8(p[1], v + 8);
#pragma unroll
                for (int x = 0; x < 16; ++x) acc[x] += v[x]; }
            if (lane < 32 && ((DBG_SEL >> 6) & 1)) { float v[16]; const u32x4* p = (const u32x4*)(prow + 6144 + c0); unpack8(p[0], v); unpack8(p[1], v + 8);
#pragma unroll
                for (int x = 0; x < 16; ++x) acc[x] += v[x]; }
            if (DBG_PHASE <= 2) {
#pragma unroll
                for (int x = 0; x < 16; ++x) acc[x] += C.small[(size_t)m * 32 + ((c0 + x) & 31)]; }
            else {
#pragma unroll
                for (int x = 0; x < 16; ++x) if ((DBG_SEL >> 7) & 1) acc[x] += C.ssm_ss[(size_t)m * 16 + x] * 1e-3f; }
        } else if (DBG_PHASE == 4) {
#pragma unroll
            for (int sct = 0; sct < 2; ++sct) { float v[16]; const u32x4* p = (const u32x4*)(C.mix + (size_t)m * MIXD + sct * 1024 + c0); unpack8(p[0], v); unpack8(p[1], v + 8);
#pragma unroll
                for (int x = 0; x < 16; ++x) acc[x] += v[x]; }
        } else if (DBG_PHASE == 5 || DBG_PHASE == 8) {
#pragma unroll
            for (int x = 0; x < 16; ++x) acc[x] = C.x1[(size_t)m * D + c0 + x];
        } else if (DBG_PHASE == 6 || DBG_PHASE == 7) {
            float v[16]; const u32x4* p = (const u32x4*)((DBG_PHASE == 6 ? C.qb : C.ao) + (size_t)m * D + c0); unpack8(p[0], v); unpack8(p[1], v + 8);
#pragma unroll
            for (int x = 0; x < 16; ++x) acc[x] = v[x];
        } else if (DBG_PHASE == 9) {
#pragma unroll
            for (int sct = 0; sct < 4; ++sct) { float v[16]; const u32x4* p = (const u32x4*)(C.hb + (size_t)m * FF + sct * 1024 + c0); unpack8(p[0], v); unpack8(p[1], v + 8);
#pragma unroll
                for (int x = 0; x < 16; ++x) acc[x] += v[x]; }
        }
        asm volatile("s_waitcnt vmcnt(0)" ::: "memory");
        float* orow = C.out + (size_t)m * D + c0;
#pragma unroll
        for (int x = 0; x < 16; ++x) orow[x] = (fabsf(acc[x]) < 1e30f) ? acc[x] : 12345.f;
    }
}
#endif

#ifndef MK_N_LAUNCHES
#define MK_N_LAUNCHES 1
#endif
constexpr int N_PHASES = 12;
constexpr int N_LAUNCHES = MK_N_LAUNCHES;
struct Args { const float* in[25]; float* out; unsigned char* ws; int ph_lo, ph_hi; };
__global__ void __launch_bounds__(NWAVES * 64, 2) fwd_kernel(Args args) {
    extern __shared__ __attribute__((aligned(16))) unsigned char lds[];
    Ctx C;
    C.lds = (LAS unsigned char*)lds;
    C.tid = threadIdx.x; C.lane = C.tid & 63; C.wave = __builtin_amdgcn_readfirstlane(C.tid >> 6);
    C.G = gridDim.x; C.bx = blockIdx.x; C.vcu = (C.G % 8 == 0) ? (C.bx % 8) * (C.G / 8) + C.bx / 8 : C.bx;
    C.x = args.in[0]; C.mem = args.in[1]; C.norm1_w = args.in[2]; C.w_in = args.in[3]; C.gdn_conv_w = args.in[4]; C.gdn_a_log = args.in[5]; C.gdn_dt_bias = args.in[6]; C.gdn_norm_w = args.in[7];
    C.ssm_conv_w = args.in[8]; C.ssm_conv_b = args.in[9]; C.ssm_a_log = args.in[10]; C.ssm_dt_bias = args.in[11]; C.ssm_d = args.in[12]; C.ssm_norm_w = args.in[13]; C.w_out = args.in[14];
    C.norm2_w = args.in[15]; C.mem_norm_w = args.in[16]; C.wq = args.in[17]; C.wk = args.in[18]; C.wv = args.in[19]; C.wo = args.in[20]; C.norm3_w = args.in[21]; C.w_up = args.in[22];
    C.w_down = args.in[23]; C.final_norm_w = args.in[24];
    C.out = args.out; C.ws = args.ws; C.dob = (unsigned char*)args.out;
    unsigned char* ws = args.ws; unsigned char* dob = C.dob;
    C.P = (bf16*)(ws + WS_P); C.Win_t = (bf16*)(ws + WS_WIN); C.Wkv_t = (bf16*)(ws + WS_WKV); C.Wout_t = (bf16*)(ws + WS_WOUT); C.Wq_t = (bf16*)(ws + WS_WQ); C.Wo_t = (bf16*)(ws + WS_WO);
    C.Wup_t = (bf16*)(ws + WS_WUP); C.Wdn_t = (bf16*)(ws + WS_WDN); C.Kmem = (bf16*)(ws + WS_KMEM); C.VT = (bf16*)(ws + WS_VT); C.MN = (bf16*)(ws + WS_MN);
    C.XN1 = (bf16*)(dob + DO_XN1); C.halo = (bf16*)(dob + DO_HALO); C.kdT = (bf16*)(dob + DO_KDT); C.attn = (bf16*)(dob + DO_ATTN); C.BT = (bf16*)(dob + DO_BT);
    C.Cc = (bf16*)(ws + WS_CC); C.CB = (bf16*)(ws + WS_CB); C.mix = (bf16*)dob; C.x1b = (bf16*)(ws + WS_X1B); C.qb = (bf16*)(ws + WS_Q); C.ao = (bf16*)(ws + WS_AO); C.hb = (bf16*)(ws + WS_HB);
    C.small = (float*)(ws + WS_SMALL); C.cdv = (float*)(ws + WS_CDV); C.ssm_ss = (float*)(ws + WS_MN); C.ssp = (float*)(ws + WS_SMALL); C.x1 = (float*)(ws + WS_X1);
    for (int u = C.tid; u < (LDS_BYTES - MISC_OFF) / 4; u += NWAVES * 64) ((LAS unsigned*)(C.lds + MISC_OFF))[u] = 0u;
    __syncthreads();
    XcdBarrier bar; bar.bar = (unsigned*)(ws + WS_CTL) + CW_BAR; bar.x = 0; bar.st = nullptr;
    if (N_LAUNCHES == 1) bar = xcd_barrier_post((unsigned*)(ws + WS_CTL) + CW_BAR, (volatile LAS unsigned*)(C.lds + MISC_OFF) + 8);
    const int lo = args.ph_lo, hi = args.ph_hi;
#ifndef PH_MASK
#define PH_MASK 0xFFF
#endif
#define IN(k) (((PH_MASK >> (k)) & 1) && lo <= (k) && (k) < hi)
#define SEAM(k) do { if (IN(k) && IN((k) + 1)) xcd_barrier(bar); } while (0)
    LAS unsigned char* ring = (LAS unsigned char*)lds;

    if (IN(0)) { p0_prologue(C); } SEAM(0);
    if (IN(1)) {
        { pg8::Gemm g{C.XN1, C.Win_t, M, NIN, D}; pg8::StaticOrder S; S.init(M, NIN, C.G, C.bx);
          pg8::EpiIn E{C.P, C.small, C.halo};
          pg8::gemm_phase<pg8::EpiIn, pg8::StaticOrder, true, true>(ring, g, S, E); }
        __syncthreads();
        { pg8::Gemm g{C.MN, C.Wkv_t, BATCH * MEMLEN, 2048, D}; pg8::StaticOrder S; S.init(BATCH * MEMLEN, 2048, C.G, C.G - 1 - C.bx);
          pg8::EpiKV E{C.Kmem, C.VT};
          pg8::gemm_phase<pg8::EpiKV, pg8::StaticOrder, true, true>(ring, g, S, E); }
    } SEAM(1);
    if (IN(2)) {
#ifndef NO_GDNPREP
        for (int un = C.vcu; un < 2048; un += C.G) gdn_prep_unit(C, un);
#endif
#ifndef NO_SSDPREP
        for (int un2 = C.vcu; un2 < 256; un2 += C.G) ssd_prep_unit(C, un2);
#endif
    } SEAM(2);
    if (IN(3)) {
        if (C.bx < 128) { const int xx = C.bx & 7, yy = C.bx >> 3;
#ifdef ONLY_EB0
            if ((yy & 7) == 0)
#endif
            gdn_scan(C, xx + 8 * (yy >> 3), yy & 7); }
#ifndef NO_SSDSCAN
        else if (C.bx < 160) { const int s = C.bx - 128; ssd_scan(C, s >> 4, s & 15); }
#endif
    } SEAM(3);
    if (IN(4)) { p4_finish(C); } SEAM(4);
    if (IN(5)) {
        pg8::Gemm g{C.mix, C.Wout_t, M, D, MIXD}; pg8::StaticOrder S; S.init(M, D, C.G, C.bx);
        pg8::EpiRes E{C.x, C.x1, C.x1b, C.ssp};
        pg8::gemm_phase<pg8::EpiRes, pg8::StaticOrder, true, true>(ring, g, S, E);
    } SEAM(5);
    if (IN(6)) {
        pg8::Gemm g{C.x1b, C.Wq_t, M, D, D}; pg8::StaticOrder S; S.init(M, D, C.G, C.bx);
        pg8::EpiScale<0> E{C.qb, D, C.ssp, 0.0625f};
        pg8::gemm_phase<pg8::EpiScale<0>, pg8::StaticOrder, true, true>(ring, g, S, E);
    } SEAM(6);
    if (IN(7)) { for (int un = C.vcu; un < 256; un += C.G) attn_unit(C, un); __syncthreads(); } SEAM(7);
    if (IN(8)) {
        pg8::Gemm g{C.ao, C.Wo_t, M, D, D}; pg8::StaticOrder S; S.init(M, D, C.G, C.bx);
        pg8::EpiRes E{C.x1, C.x1, C.x1b, C.ssp};
        pg8::gemm_phase<pg8::EpiRes, pg8::StaticOrder, true, true>(ring, g, S, E);
    } SEAM(8);
    if (IN(9)) {
        pg8::Gemm g{C.x1b, C.Wup_t, M, FF, D}; pg8::StaticOrder S; S.init(M, FF, C.G, C.bx);
        pg8::EpiScale<1> E{C.hb, FF, C.ssp, 1.0f};
        pg8::gemm_phase<pg8::EpiScale<1>, pg8::StaticOrder, true, true>(ring, g, S, E);
    } SEAM(9);
#ifdef DBG_CK
    if (0) {
#else
    if (IN(10)) {
#endif
        pg8::Gemm g{C.hb, C.Wdn_t, M, D, FF}; pg8::StaticOrder S; S.init(M, D, C.G, C.bx);
        pg8::EpiRes E{C.x1, C.out, nullptr, nullptr};
        pg8::gemm_phase<pg8::EpiRes, pg8::StaticOrder, true, true>(ring, g, S, E);
    } SEAM(10);
#ifdef DBG_CK
    if (lo == 10) { dbg_ck_a(C); }
    if (lo == 11) { dbg_ck_b(C); }
#elif defined(DBG_PHASE)
    if (lo == 11) { dbg_digest(C); }
#else
    if (IN(11)) { p11_final(C); }
#endif
#undef IN
#undef SEAM
}

extern "C" void kernel_launch(void* const* d_in, const int* in_sizes, int n_in, void* d_out, int out_size, void* d_ws, size_t ws_size, hipStream_t stream) {
    static int grid = 0;
    if (grid == 0) {
        if (n_in != 25 || in_sizes[0] != M * D || out_size != M * D || ws_size < 256 * MiB) { fprintf(stderr, "kernel_launch: unexpected problem shape (n_in %d, in0 %d, out %d, ws %zu); nothing launched\n", n_in, n_in > 0 ? in_sizes[0] : -1, out_size, ws_size); grid = -1; return; }
        int dev = 0, cus = 0, per_cu = 0;
        if (hipGetDevice(&dev) != hipSuccess || hipDeviceGetAttribute(&cus, hipDeviceAttributeMultiprocessorCount, dev) != hipSuccess) { grid = -1; return; }
        if (hipFuncSetAttribute((const void*)fwd_kernel, hipFuncAttributeMaxDynamicSharedMemorySize, LDS_BYTES) != hipSuccess) { fprintf(stderr, "kernel_launch: hipFuncSetAttribute failed\n"); grid = -1; return; }
        if (hipOccupancyMaxActiveBlocksPerMultiprocessor(&per_cu, (const void*)fwd_kernel, NWAVES * 64, LDS_BYTES) != hipSuccess || per_cu < 1)
            fprintf(stderr, "kernel_launch: note: occupancy query reports %d workgroups per CU\n", per_cu);
        (void)hipGetLastError();
        grid = cus;
        if (grid != 256) fprintf(stderr, "kernel_launch: note: %d CUs (built for 256)\n", grid);
    }
    if (grid < 0) return;
    if (hipMemsetAsync((char*)d_ws + WS_CTL, 0, CTL_ZERO_BYTES, stream) != hipSuccess) { fprintf(stderr, "kernel_launch: hipMemsetAsync failed\n"); return; }
    Args a{};
    for (int i = 0; i < 25; ++i) a.in[i] = (const float*)d_in[i];
    a.out = (float*)d_out; a.ws = (unsigned char*)d_ws;
    if (N_LAUNCHES == 1) {
        a.ph_lo = 0; a.ph_hi = N_PHASES;
        hipLaunchKernelGGL(fwd_kernel, dim3(grid), dim3(NWAVES * 64), LDS_BYTES, stream, a);
    } else {
        for (int li = 0; li < N_PHASES; ++li) {
#ifdef DBG_PHASE
#ifdef DBG_CK
            if (li > DBG_PHASE && li < 10) continue;
#else
            if (li > DBG_PHASE && li != 11) continue;
#endif
#endif
            a.ph_lo = li; a.ph_hi = li + 1; hipLaunchKernelGGL(fwd_kernel, dim3(grid), dim3(NWAVES * 64), LDS_BYTES, stream, a); }
    }
    const hipError_t le = hipPeekAtLastError();
    if (le != hipSuccess) fprintf(stderr, "kernel_launch: launch failed: %s\n", hipGetErrorName(le));
}
```

```cpp
#include <hip/hip_runtime.h>
#include <cstdio>
#include <cstdint>
namespace pg8 {
#define PG8_LAS __attribute__((address_space(3)))
typedef unsigned short bf16_t;
typedef short bf16x8 __attribute__((ext_vector_type(8)));
typedef float f32x4 __attribute__((ext_vector_type(4)));
typedef unsigned u32x4 __attribute__((ext_vector_type(4)));
constexpr int BM = 256, BK = 64, HALF = 128, HTB = HALF * BK * 2  , STAGE_BYTES = 8 * HTB, NXCD = 8, WGM = 8;

__host__ __device__ __forceinline__ int lds_byte(int r, int c) { const int st = (r >> 4) * 2 + (c >> 5), rr = r & 15, cc = c & 31, ob = rr * 64 + cc * 2; return st * 1024 + (ob ^ (((ob >> 9) & 1) << 5)); }
__host__ __device__ __forceinline__ void stage_rc(int b, int& R, int& C) { const int st = b / 1024, sb = b % 1024, swz = sb ^ (((sb >> 9) & 1) << 5); R = (st >> 1) * 16 + swz / 64; C = (st & 1) * 32 + (swz % 64) / 2; }
__host__ __device__ __forceinline__ int perm32(int rho) { const int n = rho >> 4, i = rho & 15; return 8 * (i >> 2) + 4 * n + (i & 3); }

struct Unit { int pm, pn; };
struct Gemm { const bf16_t* A; const bf16_t* Bt; int M, N, K; };

struct StaticOrder {
    int nM, nN, nwg, G, c;
    __host__ __device__ void init(int M, int N, int G_, int c_) { nM = M / BM; nN = N / BM; nwg = nM * nN; G = G_; c = c_; }
    __host__ __device__ bool next(int i, Unit& u) const {
        const long L = (long)i * G + c; if (L >= nwg) return false;
        int wgid = (int)L; { const int q = nwg / NXCD, r = nwg % NXCD, xcd = wgid % NXCD, off = wgid / NXCD; wgid = (xcd < r ? xcd * (q + 1) : r * (q + 1) + (xcd - r) * q) + off; }
        const int nig = WGM * nN, gid = wgid / nig, fm = gid * WGM, gsz = (nM - fm) < WGM ? (nM - fm) : WGM;
        u.pm = fm + ((wgid % nig) % gsz); u.pn = (wgid % nig) / gsz; return true;
    }
    __device__ __forceinline__ void a_ready(const Unit&) const {}
    __device__ __forceinline__ void done(const Unit&) const {}
};

typedef float f32x2_t __attribute__((ext_vector_type(2))); typedef __bf16 bf16x2_t __attribute__((ext_vector_type(2)));
__device__ __forceinline__ unsigned cvt_pk_bf16(float lo, float hi) { f32x2_t v = {lo, hi}; bf16x2_t b = __builtin_convertvector(v, bf16x2_t); return __builtin_bit_cast(unsigned, b); }

__device__ __forceinline__ u32x4 pack8(const f32x4 v0, const f32x4 v1) { u32x4 w; w.x = cvt_pk_bf16(v0[0], v0[1]); w.y = cvt_pk_bf16(v0[2], v0[3]); w.z = cvt_pk_bf16(v1[0], v1[1]); w.w = cvt_pk_bf16(v1[2], v1[3]); return w; }
__device__ __forceinline__ unsigned short bf1(float f) { return (unsigned short)(cvt_pk_bf16(f, 0.f) & 0xffffu); }

struct EpiIn {
    static constexpr bool PERM = true, AFTER_DRAIN = false;
    bf16_t* P; float* small; bf16_t* halo;
    __device__ __forceinline__ void operator()(const f32x4 (&acc)[2][2][4][2], const Unit& u, int wr, int wc, int fr, int fq) const {
        const int row0 = u.pm * BM + wr * 64 + fr;
        if (u.pn < 26) {
            const int col0 = u.pn * BM + wc * 32 + 8 * fq;
#pragma unroll
            for (int ai = 0; ai < 2; ++ai)
#pragma unroll
                for (int m = 0; m < 4; ++m) { const int row = row0 + ai * HALF + m * 16; bf16_t* rowp = P + (size_t)row * 6656 + col0;
#pragma unroll
                    for (int bj = 0; bj < 2; ++bj) { const u32x4 w = pack8(acc[ai][bj][m][0], acc[ai][bj][m][1]); *(u32x4*)(rowp + bj * HALF) = w;
                        if (m == 3) { if (u.pn < 12 && fr >= 13) *(u32x4*)(halo + ((size_t)(row >> 6) * 3 + (fr - 13)) * 3072 + col0 + bj * HALF) = w; } } }
        } else if (wc == 0) {
#pragma unroll
            for (int ai = 0; ai < 2; ++ai)
#pragma unroll
                for (int m = 0; m < 4; ++m) { const int row = row0 + ai * HALF + m * 16; float* sp = small + (size_t)row * 32 + 8 * fq;
                    *(f32x4*)sp = acc[ai][0][m][0]; *(f32x4*)(sp + 4) = acc[ai][0][m][1]; }
        }
    }
};
struct EpiKV {
    static constexpr bool PERM = true, AFTER_DRAIN = false;
    bf16_t* Km; bf16_t* VT;
    __device__ __forceinline__ void operator()(const f32x4 (&acc)[2][2][4][2], const Unit& u, int wr, int wc, int fr, int fq) const {
        const int row0 = u.pm * BM + wr * 64 + fr, col0 = u.pn * BM + wc * 32 + 8 * fq;
#pragma unroll
        for (int ai = 0; ai < 2; ++ai)
#pragma unroll
            for (int m = 0; m < 4; ++m) { const int row = row0 + ai * HALF + m * 16;
#pragma unroll
                for (int bj = 0; bj < 2; ++bj) { const int c = col0 + bj * HALF;
                    if (c < 1024) { *(u32x4*)(Km + (size_t)row * 1024 + c) = pack8(acc[ai][bj][m][0], acc[ai][bj][m][1]); }
                    else { const int cc = c - 1024, b = row >> 8, mm = row & 255;
#pragma unroll
                        for (int n = 0; n < 2; ++n)
#pragma unroll
                            for (int j = 0; j < 4; ++j) VT[((size_t)b * 1024 + cc + 4 * n + j) * 256 + mm] = bf1(acc[ai][bj][m][n][j]); } } }
    }
};
struct EpiRes {
    static constexpr bool PERM = true, AFTER_DRAIN = false;
    const float* base; float* out; bf16_t* outb; float* ssp;
    __device__ __forceinline__ void operator()(const f32x4 (&acc)[2][2][4][2], const Unit& u, int wr, int wc, int fr, int fq) const {
        const int row0 = u.pm * BM + wr * 64 + fr, col0 = u.pn * BM + wc * 32 + 8 * fq;
#pragma unroll
        for (int ai = 0; ai < 2; ++ai)
#pragma unroll
            for (int m = 0; m < 4; ++m) { const int row = row0 + ai * HALF + m * 16; float ss = 0.f;
#pragma unroll
                for (int bj = 0; bj < 2; ++bj) { const size_t off = (size_t)row * 1024 + col0 + bj * HALF;
                    const f32x4 v0 = *(const f32x4*)(base + off) + acc[ai][bj][m][0], v1 = *(const f32x4*)(base + off + 4) + acc[ai][bj][m][1];
                    *(f32x4*)(out + off) = v0; *(f32x4*)(out + off + 4) = v1;
                    if (outb) *(u32x4*)(outb + off) = pack8(v0, v1);
                    ss += (v0[0] * v0[0] + v0[1] * v0[1]) + (v0[2] * v0[2] + v0[3] * v0[3]) + (v1[0] * v1[0] + v1[1] * v1[1]) + (v1[2] * v1[2] + v1[3] * v1[3]); }
                ss += __shfl_xor(ss, 16); ss += __shfl_xor(ss, 32);
                if (ssp && fq == 0) ssp[(size_t)row * 16 + u.pn * 4 + wc] = ss; }
    }
};
template <int ACT> struct EpiScale {
    static constexpr bool PERM = true, AFTER_DRAIN = false;
    bf16_t* O; int ldc; const float* ssp; float scale;
    __device__ __forceinline__ void operator()(const f32x4 (&acc)[2][2][4][2], const Unit& u, int wr, int wc, int fr, int fq) const {
        const int row0 = u.pm * BM + wr * 64 + fr, col0 = u.pn * BM + wc * 32 + 8 * fq;
#pragma unroll
        for (int ai = 0; ai < 2; ++ai)
#pragma unroll
            for (int m = 0; m < 4; ++m) { const int row = row0 + ai * HALF + m * 16;
                const f32x4* sp = (const f32x4*)(ssp + (size_t)row * 16); const f32x4 s0 = sp[0], s1 = sp[1], s2 = sp[2], s3 = sp[3];
                const float tot = ((s0[0] + s0[1]) + (s0[2] + s0[3])) + ((s1[0] + s1[1]) + (s1[2] + s1[3])) + ((s2[0] + s2[1]) + (s2[2] + s2[3])) + ((s3[0] + s3[1]) + (s3[2] + s3[3]));
                const float rs = rsqrtf(tot * (1.0f / 1024.0f) + 1e-6f) * scale;
#pragma unroll
                for (int bj = 0; bj < 2; ++bj) { f32x4 v0 = acc[ai][bj][m][0] * rs, v1 = acc[ai][bj][m][1] * rs;
                    if (ACT == 1) {
#pragma unroll
                        for (int j = 0; j < 4; ++j) { const float a = fmaxf(v0[j], 0.f), b = fmaxf(v1[j], 0.f); v0[j] = a * a; v1[j] = b * b; } }
                    *(u32x4*)(O + (size_t)row * ldc + col0 + bj * HALF) = pack8(v0, v1); } }
    }
};

template <class Epi, class Sched, bool ALIGN_EPI = false, bool SP2 = false>
__device__ __forceinline__ void gemm_phase(PG8_LAS unsigned char* lds, const Gemm g, const Sched& S, const Epi& E) {
    const int tid = threadIdx.x, wid = __builtin_amdgcn_readfirstlane(tid >> 6), lane = tid & 63, wr = wid >> 2, wc = wid & 3, fr = lane & 15, fq = lane >> 4;
    const int K = g.K, nt = K / BK;
    unsigned voffA[2], voffB[2];
#pragma unroll
    for (int i = 0; i < 2; ++i) { int R, C; stage_rc(tid * 16 + i * 8192, R, C); const int Rb = Epi::PERM ? ((R & ~31) + perm32(R & 31)) : R;
        voffA[i] = (unsigned)(R * K + C) * 2u; voffB[i] = (unsigned)(Rb * K + C) * 2u; }
    const size_t kstep = (size_t)(BK * 2);
    const size_t hstep = (size_t)HALF * K * 2;
    const size_t tstep = 2 * hstep;
    const unsigned ldsw = (unsigned)wid * 1024u;
    const int aoff = lds_byte(wr * 64 + fr, fq * 8), boff = lds_byte(wc * 32 + fr, fq * 8);
#define PG8_SA(b, h) (((b) * 2 + (h)) * HTB)
#define PG8_SB(b, h) ((4 + (b) * 2 + (h)) * HTB)
#define PG8_STAGE(bufoff, gbase, voff) do { _Pragma("unroll") for (int _i = 0; _i < 2; ++_i) \
        __builtin_amdgcn_global_load_lds((const unsigned*)((const char*)(gbase) + (voff)[_i]), (PG8_LAS unsigned*)(lds + (bufoff) + ldsw + _i * 8192), 16, 0, 0); } while (0)
#define PG8_LDA(dst, b, h) do { _Pragma("unroll") for (int m = 0; m < 4; ++m) _Pragma("unroll") for (int k = 0; k < 2; ++k) dst[m][k] = *(const PG8_LAS bf16x8*)(lds + PG8_SA(b, h) + aoff + m * 2048 + k * 1024); } while (0)
#define PG8_LDB(dst, b, h) do { _Pragma("unroll") for (int n = 0; n < 2; ++n) _Pragma("unroll") for (int k = 0; k < 2; ++k) dst[n][k] = *(const PG8_LAS bf16x8*)(lds + PG8_SB(b, h) + boff + n * 2048 + k * 1024); } while (0)
#define PG8_MMA(ai, bj, At, Bt) do { __builtin_amdgcn_s_setprio(1); _Pragma("unroll") for (int m = 0; m < 4; ++m) _Pragma("unroll") for (int n = 0; n < 2; ++n) _Pragma("unroll") for (int k = 0; k < 2; ++k) \
        acc[ai][bj][m][n] = __builtin_amdgcn_mfma_f32_16x16x32_bf16(Bt[n][k], At[m][k], acc[ai][bj][m][n], 0, 0, 0); __builtin_amdgcn_s_setprio(0); } while (0)
#define PG8_WAIT_V(n) asm volatile("s_waitcnt vmcnt(" #n ")" ::: "memory")
#define PG8_WAIT_L(n) asm volatile("s_waitcnt lgkmcnt(" #n ")" ::: "memory")
#define PG8_BAR __builtin_amdgcn_s_barrier()
#define PG8_SCHED __builtin_amdgcn_sched_barrier(0)
    Unit cur, nxt; int ui = 0;
    if (!S.next(0, cur)) return;
    f32x4 acc[2][2][4][2];
#pragma unroll
    for (int a = 0; a < 2; ++a)
#pragma unroll
        for (int b = 0; b < 2; ++b)
#pragma unroll
            for (int m = 0; m < 4; ++m)
#pragma unroll
                for (int n = 0; n < 2; ++n) acc[a][b][m][n] = (f32x4){0.f, 0.f, 0.f, 0.f};
    bf16x8 At[4][2], B0[2][2], B1[2][2];
    const char* cA = (const char*)g.A + (size_t)cur.pm * tstep; const char* cB = (const char*)g.Bt + (size_t)cur.pn * tstep;
    S.a_ready(cur);
    if constexpr (SP2) {
        PG8_STAGE(PG8_SB(0, 0), cB, voffB); PG8_STAGE(PG8_SB(0, 1), cB + hstep, voffB); PG8_STAGE(PG8_SA(0, 0), cA, voffA); PG8_STAGE(PG8_SA(0, 1), cA + hstep, voffA);
        if (wr == 1) PG8_BAR;
        PG8_WAIT_V(2); PG8_BAR;
        PG8_STAGE(PG8_SB(1, 0), cB + kstep, voffB); PG8_STAGE(PG8_SA(1, 0), cA + kstep, voffA); PG8_STAGE(PG8_SB(1, 1), cB + hstep + kstep, voffB);
        PG8_WAIT_V(6); PG8_BAR;
    } else {
        PG8_STAGE(PG8_SB(0, 0), cB, voffB); PG8_STAGE(PG8_SA(0, 0), cA, voffA); PG8_STAGE(PG8_SB(0, 1), cB + hstep, voffB); PG8_STAGE(PG8_SA(0, 1), cA + hstep, voffA);
        if (wr == 1) PG8_BAR;
        PG8_WAIT_V(4); PG8_BAR;
        PG8_STAGE(PG8_SB(1, 0), cB + kstep, voffB); PG8_STAGE(PG8_SA(1, 0), cA + kstep, voffA); PG8_STAGE(PG8_SB(1, 1), cB + hstep + kstep, voffB);
        PG8_WAIT_V(6); PG8_BAR;
    }
    for (;;) {
        const bool has_next = S.next(ui + 1, nxt);
        const char* nA = has_next ? (const char*)g.A + (size_t)nxt.pm * tstep : cA; const char* nB = has_next ? (const char*)g.Bt + (size_t)nxt.pn * tstep : cB;
        for (int t = 0; t < nt; t += 2) {
            const bool last = (t == nt - 2);
            const char* a1 = cA + (size_t)(t + 1) * kstep;
            const char* a2 = last ? nA : cA + (size_t)(t + 2) * kstep; const char* b2 = last ? nB : cB + (size_t)(t + 2) * kstep;
            const char* a3 = a2 + kstep; const char* b3 = b2 + kstep;
            if (last && has_next) S.a_ready(nxt);
            if constexpr (SP2) {
            PG8_LDB(B0, 0, 0); PG8_LDB(B1, 0, 1); PG8_SCHED; PG8_LDA(At, 0, 0); PG8_STAGE(PG8_SA(1, 1), a1 + hstep, voffA);
            PG8_WAIT_V(8); PG8_WAIT_L(0); PG8_BAR; PG8_MMA(0, 0, At, B0); PG8_MMA(0, 1, At, B1); PG8_BAR; PG8_SCHED;
            PG8_LDA(At, 0, 1); PG8_STAGE(PG8_SB(0, 0), b2, voffB); PG8_STAGE(PG8_SB(0, 1), b2 + hstep, voffB); PG8_STAGE(PG8_SA(0, 0), a2, voffA);
            PG8_WAIT_V(8); PG8_WAIT_L(0); PG8_BAR; PG8_MMA(1, 0, At, B0); PG8_MMA(1, 1, At, B1); PG8_BAR; PG8_SCHED;
            PG8_LDB(B0, 1, 0); PG8_LDB(B1, 1, 1); PG8_SCHED; PG8_LDA(At, 1, 0); PG8_STAGE(PG8_SA(0, 1), a2 + hstep, voffA);
            PG8_WAIT_V(8); PG8_WAIT_L(0); PG8_BAR; PG8_MMA(0, 0, At, B0); PG8_MMA(0, 1, At, B1); PG8_BAR; PG8_SCHED;
            PG8_LDA(At, 1, 1); PG8_STAGE(PG8_SB(1, 0), b3, voffB); PG8_STAGE(PG8_SB(1, 1), b3 + hstep, voffB); PG8_STAGE(PG8_SA(1, 0), a3, voffA);
            PG8_WAIT_V(8); PG8_WAIT_L(0); PG8_BAR; PG8_MMA(1, 0, At, B0); PG8_MMA(1, 1, At, B1); PG8_BAR; PG8_SCHED;
            } else {
            PG8_LDB(B0, 0, 0); PG8_SCHED; PG8_LDA(At, 0, 0); PG8_STAGE(PG8_SA(1, 1), a1 + hstep, voffA);
            PG8_WAIT_L(8); PG8_BAR; PG8_WAIT_L(0); PG8_MMA(0, 0, At, B0); PG8_BAR; PG8_SCHED;
            PG8_LDB(B1, 0, 1); PG8_STAGE(PG8_SB(0, 0), b2, voffB);
            PG8_BAR; PG8_WAIT_L(0); PG8_MMA(0, 1, At, B1); PG8_BAR;
            PG8_LDA(At, 0, 1); PG8_STAGE(PG8_SA(0, 0), a2, voffA);
            PG8_BAR; PG8_WAIT_L(0); PG8_MMA(1, 0, At, B0); PG8_BAR; PG8_SCHED;
            PG8_STAGE(PG8_SB(0, 1), b2 + hstep, voffB);
            PG8_WAIT_V(6); PG8_BAR; PG8_MMA(1, 1, At, B1); PG8_BAR;
            PG8_LDB(B0, 1, 0); PG8_SCHED; PG8_LDA(At, 1, 0); PG8_STAGE(PG8_SA(0, 1), a2 + hstep, voffA);
            PG8_WAIT_L(8); PG8_BAR; PG8_WAIT_L(0); PG8_MMA(0, 0, At, B0); PG8_BAR; PG8_SCHED;
            PG8_LDB(B1, 1, 1); PG8_STAGE(PG8_SB(1, 0), b3, voffB);
            PG8_BAR; PG8_WAIT_L(0); PG8_MMA(0, 1, At, B1); PG8_BAR;
            PG8_LDA(At, 1, 1); PG8_STAGE(PG8_SA(1, 0), a3, voffA);
            PG8_BAR; PG8_WAIT_L(0); PG8_MMA(1, 0, At, B0); PG8_BAR; PG8_SCHED;
            PG8_STAGE(PG8_SB(1, 1), b3 + hstep, voffB);
            PG8_WAIT_V(6); PG8_BAR; PG8_MMA(1, 1, At, B1); PG8_BAR;
            }
        }
        if constexpr (ALIGN_EPI) { if (wr == 0) PG8_BAR; }
        if constexpr (!Epi::AFTER_DRAIN) { E(acc, cur, wr, wc, fr, fq); S.done(cur); }
        if (!has_next) break;
#pragma unroll
        for (int a = 0; a < 2; ++a)
#pragma unroll
            for (int b = 0; b < 2; ++b)
#pragma unroll
                for (int m = 0; m < 4; ++m)
#pragma unroll
                    for (int n = 0; n < 2; ++n) acc[a][b][m][n] = (f32x4){0.f, 0.f, 0.f, 0.f};
        cur = nxt; cA = nA; cB = nB; ++ui;
        if constexpr (ALIGN_EPI) { if (wr == 1) PG8_BAR; }
    }
    PG8_WAIT_V(0);
    if constexpr (!ALIGN_EPI) { if (wr == 0) PG8_BAR; }
    PG8_BAR;
    if constexpr (Epi::AFTER_DRAIN) { E.fused(acc, cur, wr, wc, fr, fq, lds, wid, lane); S.done(cur); }
#undef PG8_SA
#undef PG8_SB
#undef PG8_STAGE
#undef PG8_LDA
#undef PG8_LDB
#undef PG8_MMA
#undef PG8_WAIT_V
#undef PG8_WAIT_L
#undef PG8_BAR
#undef PG8_SCHED
}
}

constexpr int NWAVES = 8;
constexpr int BATCH = 2, T = 8192, D = 1024, M = BATCH * T, FF = 4096, MIXD = 2048, MEMLEN = 256;
constexpr int NP = 6656;
constexpr int NIN = 6912;
constexpr int PQ = 0, PK = 1024, PV = 2048, PZG = 3072, PZS = 4096, PXS = 5120, PB = 6144, PC = 6400;
constexpr float EPS = 1e-6f;
constexpr size_t MiB = 1u << 20;
constexpr size_t WS_CTL = 0, CTL_ZERO_BYTES = 64 * 1024;
constexpr size_t WS_CDV = 512 * 1024;
constexpr size_t WS_P = 1 * MiB;
constexpr size_t WS_WIN = 209 * MiB;
constexpr size_t WS_WKV = WS_WIN + 13 * MiB + 512 * 1024;
constexpr size_t WS_WOUT = WS_WKV + 4 * MiB;
constexpr size_t WS_WQ = WS_WOUT + 4 * MiB, WS_WO = WS_WQ + 2 * MiB, WS_WUP = WS_WO + 2 * MiB, WS_WDN = WS_WUP + 8 * MiB;
constexpr size_t WS_KMEM = WS_WDN + 8 * MiB;
constexpr size_t WS_VT = WS_KMEM + 1 * MiB;
constexpr size_t WS_MN = WS_VT + 1 * MiB;
constexpr size_t WS_SMALL = WS_MN + 1 * MiB;
constexpr size_t WS_END = WS_SMALL + 2 * MiB;
static_assert(WS_END <= 256 * MiB, "d_ws map");
constexpr size_t WS_CC = WS_WIN, WS_CB = WS_WIN + 8 * MiB;
static_assert(WS_CB + 8 * MiB <= WS_WOUT, "CB overlays w_in tail + wkv only");
constexpr size_t WS_X1 = 1 * MiB, WS_X1B = 65 * MiB, WS_Q = 97 * MiB, WS_AO = 129 * MiB, WS_HB = 97 * MiB;
static_assert(WS_HB + 128 * MiB <= WS_WOUT, "hb overlay");
constexpr size_t DO_XN1 = 0, DO_KDT = 0, DO_ATTN = 32 * MiB, DO_HALO = 48 * MiB, DO_BT = 52 * MiB + 512 * 1024;
constexpr int CW_BAR = 4096;
constexpr int RING_BYTES = 131072;
constexpr int LDS_BYTES = 147456;
constexpr int MISC_OFF = LDS_BYTES - 512;

#define GAS __attribute__((address_space(1)))
#define LAS __attribute__((address_space(3)))
typedef unsigned short bf16;
typedef unsigned u32x4 __attribute__((ext_vector_type(4)));
typedef unsigned u32x2 __attribute__((ext_vector_type(2)));
typedef float f32x4 __attribute__((ext_vector_type(4)));
typedef short bf16x8 __attribute__((ext_vector_type(8)));
typedef GAS unsigned gu32;
#define RLX_AGENT __ATOMIC_RELAXED, __HIP_MEMORY_SCOPE_AGENT
#define LDS_WAIT() asm volatile("s_waitcnt lgkmcnt(0)" ::: "memory")
#define VM_WAIT() asm volatile("s_waitcnt vmcnt(0)" ::: "memory")
__device__ __forceinline__ unsigned pk2(float lo, float hi) { return pg8::cvt_pk_bf16(lo, hi); }
__device__ __forceinline__ bf16 f2bf(float f) { return (bf16)(pk2(f, 0.f) & 0xffffu); }
__device__ __forceinline__ float bf2f(bf16 b) { return __uint_as_float((unsigned)b << 16); }
__device__ __forceinline__ float bflo(unsigned w) { return __uint_as_float(w << 16); }
__device__ __forceinline__ float bfhi(unsigned w) { return __uint_as_float(w & 0xffff0000u); }
__device__ __forceinline__ void unpack8(const u32x4 w, float* f) { f[0] = bflo(w.x); f[1] = bfhi(w.x); f[2] = bflo(w.y); f[3] = bfhi(w.y); f[4] = bflo(w.z); f[5] = bfhi(w.z); f[6] = bflo(w.w); f[7] = bfhi(w.w); }
__device__ __forceinline__ u32x4 pack8f(const float* f) { u32x4 w; w.x = pk2(f[0], f[1]); w.y = pk2(f[2], f[3]); w.z = pk2(f[4], f[5]); w.w = pk2(f[6], f[7]); return w; }
__device__ __forceinline__ u32x2 pack4(const f32x4 v) { u32x2 w; w.x = pk2(v[0], v[1]); w.y = pk2(v[2], v[3]); return w; }
__device__ __forceinline__ float silu_f(float y) { return y / (1.f + __expf(-y)); }
__device__ __forceinline__ float sigmoid_f(float y) { return 1.f / (1.f + __expf(-y)); }
__device__ __forceinline__ float softplus_f(float x) { return fmaxf(x, 0.f) + log1pf(__expf(-fabsf(x))); }
__device__ __forceinline__ f32x4 mfma16(bf16x8 a, bf16x8 b, f32x4 c) { return __builtin_amdgcn_mfma_f32_16x16x32_bf16(a, b, c, 0, 0, 0); }
__device__ __forceinline__ float wave_sum(float v) {
#pragma unroll
    for (int o = 1; o < 64; o <<= 1) v += __shfl_xor(v, o);
    return v;
}
__device__ __forceinline__ int opaque(int x) { asm volatile("" : "+v"(x)); return x; }
#define XB_TMO      128
#define XB_XCNT(j)  (256  + 64 * (j))
#define XB_XSUB(j)  (1280 + 64 * (j))
#define XB_XGEN(j)  (2304 + 64 * (j))
#define XB_TOP      3328
#define XB_TOPGEN   3392
#define XCD_BAR_WORDS 3456
#define XB_SPIN_CAP (1u << 18)

__device__ __forceinline__ unsigned xb_ld(unsigned* p)              { return __hip_atomic_load(p, __ATOMIC_RELAXED, __HIP_MEMORY_SCOPE_AGENT); }
__device__ __forceinline__ unsigned xb_add(unsigned* p, unsigned v) { return __hip_atomic_fetch_add(p, v, __ATOMIC_RELAXED, __HIP_MEMORY_SCOPE_AGENT); }
__device__ __forceinline__ unsigned xb_xcc_id() { return (unsigned)__builtin_amdgcn_s_getreg((3 << 11) | 20) & 0xFu; }
#define XB_SPIN(cond, bar) do { unsigned _sp = 0; while (cond) { __builtin_amdgcn_s_sleep(1); \
    if ((++_sp & 255u) == 0u) { if (xb_ld(&(bar)[XB_TMO])) break; if (_sp > XB_SPIN_CAP) { atomicAdd(&(bar)[XB_TMO], 1u); break; } } } } while (0)

struct XcdBarrier {
    unsigned* bar; unsigned x;
    volatile LAS unsigned* st;
};

__device__ __forceinline__ XcdBarrier xcd_barrier_post(unsigned* bar, volatile LAS unsigned* st) {
    XcdBarrier b; b.bar = bar; b.x = xb_xcc_id(); b.st = st;
    if (threadIdx.x == 0) (void)xb_add(&bar[XB_XCNT(b.x)], 1u);
    return b;
}
__device__ __forceinline__ void xcd_barrier_complete(unsigned* bar, unsigned x, unsigned& nloc, unsigned& nx) {
    const unsigned G = gridDim.x * gridDim.y * gridDim.z;
    unsigned sum, cnt, mine, sp = 0u;
    for (;;) {
        sum = 0u; cnt = 0u; mine = 0u;
#pragma unroll
        for (unsigned j = 0; j < 16; ++j) { const unsigned c = xb_ld(&bar[XB_XCNT(j)]); sum += c; cnt += (c > 0u) ? 1u : 0u; mine = (j == x) ? c : mine; }
        if (sum == G) break;
        __builtin_amdgcn_s_sleep(1);
        if ((++sp & 255u) == 0u) { if (xb_ld(&bar[XB_TMO])) break; if (sp > XB_SPIN_CAP) { atomicAdd(&bar[XB_TMO], 1u); break; } }
    }
    nloc = mine > 0u ? mine : 1u; nx = cnt > 0u ? cnt : 1u;
}

__device__ __forceinline__ void xcd_barrier(const XcdBarrier& b) {
    asm volatile("s_waitcnt vmcnt(0)" ::: "memory");
    __syncthreads();
    if (threadIdx.x == 0) {
        unsigned* bar = b.bar;
        __builtin_amdgcn_s_waitcnt(0);
        unsigned nloc = b.st[0], nx = b.st[1];
        if (nloc == 0u) { xcd_barrier_complete(bar, b.x, nloc, nx); b.st[0] = nloc; b.st[1] = nx; }
        const unsigned old = xb_add(&bar[XB_XSUB(b.x)], 1u);
        const unsigned gen = old / nloc;
        if (old + 1u == (gen + 1u) * nloc) {
            __builtin_amdgcn_fence(__ATOMIC_RELEASE, "agent");
            asm volatile("s_waitcnt vmcnt(0)" ::: "memory");
            const unsigned og = xb_add(&bar[XB_TOP], 1u);
            const unsigned tg = og / nx;
            if (og + 1u == (tg + 1u) * nx) xb_add(&bar[XB_TOPGEN], 1u);
            else XB_SPIN(xb_ld(&bar[XB_TOPGEN]) == tg, bar);
            __builtin_amdgcn_fence(__ATOMIC_ACQUIRE, "agent");
            xb_add(&bar[XB_XGEN(b.x)], 1u);
            asm volatile("s_waitcnt vmcnt(0)" ::: "memory");
        } else {
            XB_SPIN(xb_ld(&bar[XB_XGEN(b.x)]) == gen, bar);
            __builtin_amdgcn_fence(__ATOMIC_ACQUIRE, "agent");
            asm volatile("s_waitcnt vmcnt(0)" ::: "memory");
        }
    }
    __syncthreads();
}

struct Ctx {
    LAS unsigned char* lds;
    int tid, lane, wave, vcu, G, bx;
    const float *x, *mem, *norm1_w, *w_in, *gdn_conv_w, *gdn_a_log, *gdn_dt_bias, *gdn_norm_w, *ssm_conv_w, *ssm_conv_b, *ssm_a_log, *ssm_dt_bias, *ssm_d, *ssm_norm_w,
                *w_out, *norm2_w, *mem_norm_w, *wq, *wk, *wv, *wo, *norm3_w, *w_up, *w_down, *final_norm_w;
    float* out;
    unsigned char* ws; unsigned char* dob;
    bf16 *P, *Win_t, *Wkv_t, *Wout_t, *Wq_t, *Wo_t, *Wup_t, *Wdn_t, *Kmem, *VT, *MN, *XN1, *halo, *kdT, *attn, *BT, *Cc, *CB, *mix, *x1b, *qb, *ao, *hb;
    float *small, *cdv, *ssm_ss, *ssp, *x1;
};

template <class SrcCol>
__device__ __forceinline__ void p0_item(const float* W, int K, int Nsrc, bf16* WT, int nblk, LAS float* scr, int item, int lane, const float* kscale, SrcCol srccol) {
    const int kb = item / nblk, nb = item % nblk, k0 = 64 * kb, n0 = 32 * nb;
    const int sc = srccol(n0 + (lane & 31));
#pragma unroll 8
    for (int i = 0; i < 32; ++i) { const int kk = 2 * i + (lane >> 5); float v = sc >= 0 ? W[(size_t)(k0 + kk) * Nsrc + sc] : 0.f; if (kscale) v *= kscale[k0 + kk]; scr[kk * 33 + (lane & 31)] = v; }
    LDS_WAIT(); asm volatile("" ::: "memory");
    const int c = lane & 7;
#pragma unroll
    for (int j = 0; j < 4; ++j) { const int n = (lane >> 3) + 8 * j; const LAS float* s = scr + (8 * c) * 33 + n;
        u32x4 o; o.x = pk2(s[0 * 33], s[1 * 33]); o.y = pk2(s[2 * 33], s[3 * 33]); o.z = pk2(s[4 * 33], s[5 * 33]); o.w = pk2(s[6 * 33], s[7 * 33]);
        *(u32x4*)(WT + (size_t)(n0 + n) * K + k0 + 8 * c) = o; }
    LDS_WAIT(); asm volatile("" ::: "memory");
}
__device__ __forceinline__ void rms_row_to_bf16(const float* xrow, const float* w, bf16* orow, int lane) {
    const f32x4* xr = (const f32x4*)xrow + lane; const f32x4* wr = (const f32x4*)w + lane;
    f32x4 v[4]; float s = 0.f;
#pragma unroll
    for (int j = 0; j < 4; ++j) { v[j] = xr[64 * j]; s += (v[j][0] * v[j][0] + v[j][1] * v[j][1]) + (v[j][2] * v[j][2] + v[j][3] * v[j][3]); }
    const float rstd = rsqrtf(wave_sum(s) * (1.f / 1024.f) + EPS);
    u32x2* o8 = (u32x2*)orow + lane;
#pragma unroll
    for (int j = 0; j < 4; ++j) { const f32x4 o = v[j] * rstd * wr[64 * j]; o8[64 * j] = pack4(o); }
}
__device__ __forceinline__ void p0_prologue(const Ctx& C) {
    LAS float* scr = (LAS float*)(C.lds + C.wave * 16384);
    const int gw = C.vcu * NWAVES + C.wave, NGW = C.G * NWAVES, lane = C.lane;
    constexpr int I_IN = 16 * 216, I_KV = 16 * 32, I_OUT = 32 * 32, I_Q = 16 * 32, I_UP = 16 * 128, I_DN = 64 * 32;
    constexpr int NITEMS = I_IN + 2 * I_KV + I_OUT + 2 * I_Q + I_UP + I_DN;
    for (int it = gw; it < NITEMS; it += NGW) {
        int r = it;
        if (r < I_IN) { p0_item(C.w_in, 1024, 6688, C.Win_t, 216, scr, r, lane, nullptr,
                                [](int n) { return n < 4096 ? n : (n < 6656 ? n + 16 : (n < 6672 ? n - 2560 : (n < 6688 ? n : -1))); }); continue; } r -= I_IN;
        if (r < I_KV) { p0_item(C.wk, 1024, 1024, C.Wkv_t, 32, scr, r, lane, nullptr, [](int n) { return n; }); continue; } r -= I_KV;
        if (r < I_KV) { p0_item(C.wv, 1024, 1024, C.Wkv_t + (size_t)1024 * 1024, 32, scr, r, lane, nullptr, [](int n) { return n; }); continue; } r -= I_KV;
        if (r < I_OUT) { p0_item(C.w_out, 2048, 1024, C.Wout_t, 32, scr, r, lane, nullptr, [](int n) { return n; }); continue; } r -= I_OUT;
        if (r < I_Q) { p0_item(C.wq, 1024, 1024, C.Wq_t, 32, scr, r, lane, C.norm2_w, [](int n) { return n; }); continue; } r -= I_Q;
        if (r < I_Q) { p0_item(C.wo, 1024, 1024, C.Wo_t, 32, scr, r, lane, nullptr, [](int n) { return n; }); continue; } r -= I_Q;
        if (r < I_UP) { p0_item(C.w_up, 1024, 4096, C.Wup_t, 128, scr, r, lane, C.norm3_w, [](int n) { return n; }); continue; } r -= I_UP;
        p0_item(C.w_down, 4096, 1024, C.Wdn_t, 32, scr, r, lane, nullptr, [](int n) { return n; });
    }
    for (int m = gw; m < M; m += NGW) rms_row_to_bf16(C.x + (size_t)m * D, C.norm1_w, C.XN1 + (size_t)m * D, lane);
    for (int m = gw; m < BATCH * MEMLEN; m += NGW) rms_row_to_bf16(C.mem + (size_t)m * D, C.mem_norm_w, C.MN + (size_t)m * D, lane);
}

__device__ __forceinline__ void gdn_conv16(const Ctx& C, int t0, int gc, int c, int i, int col, float* outv) {
    float acc[16];
#pragma unroll
    for (int x = 0; x < 16; ++x) acc[x] = 0.f;
#pragma unroll
    for (int kk = 0; kk < 4; ++kk) {
        const int ri = i - 3 + kk;
        u32x4 a = (u32x4){0u, 0u, 0u, 0u}, b = a;
        if (ri >= 0) { const u32x4* s = (const u32x4*)(C.P + (size_t)(t0 + ri) * NP + col); a = s[0]; b = s[1]; }
        else if (c != 0) { const u32x4* s = (const u32x4*)(C.halo + ((size_t)(gc - 1) * 3 + (3 + ri)) * 3072 + col); a = s[0]; b = s[1]; }
        float xv[16]; unpack8(a, xv); unpack8(b, xv + 8);
        const f32x4* wp = (const f32x4*)(C.gdn_conv_w + (size_t)kk * 3072 + col);
#pragma unroll
        for (int j = 0; j < 4; ++j) { const f32x4 w = wp[j];
#pragma unroll
            for (int e = 0; e < 4; ++e) acc[4 * j + e] += w[e] * xv[4 * j + e]; }
    }
#pragma unroll
    for (int x = 0; x < 16; ++x) outv[x] = silu_f(acc[x]);
}
__device__ __forceinline__ void gdn_prep_unit(const Ctx& C, int un, bool st = true) {
    const int wv = C.wave;
#define GP_IDX() const int tid = opaque(C.tid), lane = tid & 63, r = lane & 15, q = lane >> 4; (void)r; (void)q; (void)lane;
    const int b = un >> 10, h = (un >> 7) & 7, c = un & 127;
    const int t0 = b * T + c * 64, gc = b * 128 + c;
    LAS bf16* QN = (LAS bf16*)(C.lds + 0);
    LAS bf16* KN = (LAS bf16*)(C.lds + 17408);
    LAS bf16* KB = (LAS bf16*)(C.lds + 34816);
    LAS bf16* VBT = (LAS bf16*)(C.lds + 52224);
    LAS bf16* KBGT = (LAS bf16*)(C.lds + 70656);
    LAS float* LM = (LAS float*)(C.lds + 89088);
    LAS bf16* TB = (LAS bf16*)(C.lds + 105728);
    LAS float* GCS = (LAS float*)(C.lds + 114944);
    LAS bf16* KDT = (LAS bf16*)(C.lds + 115200);
    float qv[16], kv[16];
    {
        GP_IDX(); const int i = tid >> 3, d0 = (tid & 7) * 16;
        const float beta = sigmoid_f(C.small[(size_t)(t0 + i) * 32 + h]);
        {
            gdn_conv16(C, t0, gc, c, i, PQ + h * 128 + d0, qv); asm volatile("" ::: "memory");
            float sq = 0.f;
#pragma unroll
            for (int x = 0; x < 16; ++x) sq += qv[x] * qv[x];
            sq += __shfl_xor(sq, 1); sq += __shfl_xor(sq, 2); sq += __shfl_xor(sq, 4);
            const float rq = rsqrtf(sq + EPS) * 0.08838834764831845f;
#pragma unroll
            for (int x = 0; x < 16; ++x) qv[x] *= rq;
            *(LAS u32x4*)(QN + i * 136 + d0) = pack8f(qv); *(LAS u32x4*)(QN + i * 136 + d0 + 8) = pack8f(qv + 8);
        }
        {
            gdn_conv16(C, t0, gc, c, i, PK + h * 128 + d0, kv); asm volatile("" ::: "memory");
            float sk = 0.f;
#pragma unroll
            for (int x = 0; x < 16; ++x) sk += kv[x] * kv[x];
            sk += __shfl_xor(sk, 1); sk += __shfl_xor(sk, 2); sk += __shfl_xor(sk, 4);
            const float rk = rsqrtf(sk + EPS);
            float t1[16];
#pragma unroll
            for (int x = 0; x < 16; ++x) { kv[x] *= rk; t1[x] = kv[x] * beta; }
            *(LAS u32x4*)(KN + i * 136 + d0) = pack8f(kv); *(LAS u32x4*)(KN + i * 136 + d0 + 8) = pack8f(kv + 8);
            *(LAS u32x4*)(KB + i * 136 + d0) = pack8f(t1); *(LAS u32x4*)(KB + i * 136 + d0 + 8) = pack8f(t1 + 8);
        }
        {
            float vv[16];
            gdn_conv16(C, t0, gc, c, i, PV + h * 128 + d0, vv); asm volatile("" ::: "memory");
            LAS bf16* vb = VBT + d0 * 72 + i;
#pragma unroll
            for (int x = 0; x < 16; ++x) vb[x * 72] = f2bf(vv[x] * beta);
        }
        if (tid < 64) {
            float g = -expf(C.gdn_a_log[h]) * softplus_f(C.small[(size_t)(t0 + tid) * 32 + 8 + h] + C.gdn_dt_bias[h]);
#pragma unroll
            for (int o = 1; o < 64; o <<= 1) { const float v2 = __shfl_up(g, o); if (lane >= o) g += v2; }
            GCS[tid] = g;
        }
    }
    __syncthreads();
    {
        GP_IDX(); const int i = tid >> 3, d0 = (tid & 7) * 16;
        const float gi = GCS[i], gl = GCS[63];
        const float eg = expf(gi), ek = expf(gl - gi);
        const float beta = sigmoid_f(C.small[(size_t)(t0 + i) * 32 + h]);
        {
            float t2[16];
#pragma unroll
            for (int x = 0; x < 16; ++x) t2[x] = qv[x] * eg;
            u32x4* qd = (u32x4*)(C.P + (size_t)(t0 + i) * NP + PQ + h * 128 + d0); if (st) { qd[0] = pack8f(t2); qd[1] = pack8f(t2 + 8); }
        }
        LAS bf16* kg = KBGT + d0 * 72 + i; LAS bf16* kd = KDT + d0 * 72 + i; const float bg = beta * eg;
#pragma unroll
        for (int x = 0; x < 16; ++x) { kg[x * 72] = f2bf(kv[x] * bg); kd[x * 72] = f2bf(kv[x] * ek); }
        if (tid == 0 && st) C.cdv[un] = expf(gl);
    }
    __syncthreads();
    {
        GP_IDX();
        const int mt = wv & 3, which = wv >> 2;
        const LAS bf16* X = which ? QN : KB;
        bf16x8 xa[4];
#pragma unroll
        for (int ks = 0; ks < 4; ++ks) xa[ks] = *(const LAS bf16x8*)(X + (16 * mt + r) * 136 + 32 * ks + 8 * q);
#pragma unroll
        for (int nt = 0; nt < 4; ++nt) {
            bf16x8 kf[4];
#pragma unroll
            for (int ks = 0; ks < 4; ++ks) kf[ks] = *(const LAS bf16x8*)(KN + (16 * nt + r) * 136 + 32 * ks + 8 * q);
            f32x4 acc = (f32x4){0.f, 0.f, 0.f, 0.f};
            if (which == 0) {
#pragma unroll
                for (int ks = 0; ks < 4; ++ks) acc = mfma16(xa[ks], kf[ks], acc);
                const int jj = 16 * nt + r; const float gj = GCS[jj];
#pragma unroll
                for (int t = 0; t < 4; ++t) { const int ii = 16 * mt + 4 * q + t; LM[ii * 65 + jj] = (ii > jj) ? acc[t] * expf(GCS[ii] - gj) : 0.f; }
            } else {
#pragma unroll
                for (int ks = 0; ks < 4; ++ks) acc = mfma16(kf[ks], xa[ks], acc);
                const int ii = 16 * mt + r; const float gi = GCS[ii]; f32x4 o;
#pragma unroll
                for (int t = 0; t < 4; ++t) { const int jj = 16 * nt + 4 * q + t; o[t] = (ii >= jj) ? acc[t] * expf(gi - GCS[jj]) : 0.f; }
                if (st) *(u32x2*)(C.attn + ((size_t)un * 64 + ii) * 64 + 16 * nt + 4 * q) = pack4(o);
            }
        }
        for (int ch = tid; ch < 1024; ch += 512) { const int d = ch >> 3, part = ch & 7;
            const u32x4 kv_ = *(const LAS u32x4*)(KDT + d * 72 + part * 8); if (st) *(u32x4*)(C.kdT + ((size_t)un * 128 + d) * 64 + part * 8) = kv_; }
    }
    __syncthreads();
    LAS float* TM = (LAS float*)(C.lds + 115200);
    LAS float* XS = (LAS float*)(C.lds + 105728);
    if (wv < 4) {
        GP_IDX(); const int base = 16 * wv, cc = lane & 15;
        float tc[16];
#pragma unroll
        for (int i2 = 0; i2 < 16; ++i2) { float a = (i2 == cc) ? 1.f : 0.f;
#pragma unroll
            for (int j = 0; j < i2; ++j) a -= LM[(base + i2) * 65 + base + j] * tc[j];
            tc[i2] = a; }
        if (lane < 16) {
#pragma unroll
            for (int i2 = 0; i2 < 16; ++i2) TM[(base + i2) * 65 + base + cc] = tc[i2]; }
    }
    __syncthreads();
#pragma unroll
    for (int I = 1; I < 4; ++I) {
        if (wv < I) {
            GP_IDX(); const int J = wv;
            f32x4 X = (f32x4){0.f, 0.f, 0.f, 0.f};
            for (int K = J; K < I; ++K) {
#pragma unroll
                for (int kk = 0; kk < 4; ++kk) { const float av = LM[(16 * I + r) * 65 + 16 * K + 4 * kk + q], bv = TM[(16 * K + 4 * kk + q) * 65 + 16 * J + r];
                    X = __builtin_amdgcn_mfma_f32_16x16x4f32(av, bv, X, 0, 0, 0); }
            }
            LAS float* xs = XS + wv * 272;
#pragma unroll
            for (int t = 0; t < 4; ++t) xs[(4 * q + t) * 17 + r] = X[t];
            LDS_WAIT(); asm volatile("" ::: "memory");
            f32x4 Y = (f32x4){0.f, 0.f, 0.f, 0.f};
#pragma unroll
            for (int kk = 0; kk < 4; ++kk) { const float av = TM[(16 * I + r) * 65 + 16 * I + 4 * kk + q], bv = xs[(4 * kk + q) * 17 + r];
                Y = __builtin_amdgcn_mfma_f32_16x16x4f32(av, bv, Y, 0, 0, 0); }
#pragma unroll
            for (int t = 0; t < 4; ++t) TM[(16 * I + 4 * q + t) * 65 + 16 * J + r] = -Y[t];
        }
        __syncthreads();
    }
    {
        GP_IDX(); const int i = tid >> 3;
        const int j0 = (tid & 7) * 8; float tv[8];
#pragma unroll
        for (int x = 0; x < 8; ++x) tv[x] = (j0 + x <= i) ? TM[i * 65 + j0 + x] : 0.f;
        *(LAS u32x4*)(TB + i * 72 + j0) = pack8f(tv);
    }
    __syncthreads();
    {
        GP_IDX();
        const int nt = wv;
        bf16x8 va[2], ka[2];
#pragma unroll
        for (int ks = 0; ks < 2; ++ks) { va[ks] = *(const LAS bf16x8*)(VBT + (16 * nt + r) * 72 + 32 * ks + 8 * q); ka[ks] = *(const LAS bf16x8*)(KBGT + (16 * nt + r) * 72 + 32 * ks + 8 * q); }
#pragma unroll
        for (int mt = 0; mt < 4; ++mt) {
            bf16x8 tf[2];
#pragma unroll
            for (int ks = 0; ks < 2; ++ks) tf[ks] = *(const LAS bf16x8*)(TB + (16 * mt + r) * 72 + 32 * ks + 8 * q);
            f32x4 au = (f32x4){0.f, 0.f, 0.f, 0.f}, aw = au;
            au = mfma16(va[0], tf[0], au); au = mfma16(va[1], tf[1], au);
            aw = mfma16(ka[0], tf[0], aw); aw = mfma16(ka[1], tf[1], aw);
            bf16* rowp = C.P + (size_t)(t0 + 16 * mt + r) * NP + h * 128 + 16 * nt + 4 * q;
            if (st) { *(u32x2*)(rowp + PV) = pack4(au); *(u32x2*)(rowp + PK) = pack4(aw); }
        }
    }
    __syncthreads();
#undef GP_IDX
}
__device__ __forceinline__ void ssd_prep_unit(const Ctx& C, int un2, bool stf = true) {
    const int tid = C.tid, lane = C.lane, wv = C.wave, r = lane & 15, q = lane >> 4;
    const int b = un2 >> 7, c = (un2 >> 1) & 63, gg = un2 & 1;
    const int t0 = b * T + c * 128;
    LAS bf16* CS = (LAS bf16*)(C.lds + 0);
    LAS bf16* BS = (LAS bf16*)(C.lds + 34816);
    LAS bf16* BTS = (LAS bf16*)(C.lds + 69632);
    const int l = tid >> 2, n0 = (tid & 3) * 32;
#pragma unroll
    for (int tensor = 0; tensor < 2; ++tensor) {
        const int colP = (tensor ? PC : PB) + gg * 128 + n0, ch = 1024 + tensor * 256 + gg * 128 + n0;
        float acc[32];
#pragma unroll
        for (int j = 0; j < 8; ++j) { const f32x4 bv = *(const f32x4*)(C.ssm_conv_b + ch + 4 * j); acc[4 * j] = bv[0]; acc[4 * j + 1] = bv[1]; acc[4 * j + 2] = bv[2]; acc[4 * j + 3] = bv[3]; }
#pragma unroll
        for (int kk = 0; kk < 4; ++kk) {
            const int rl = c * 128 + l - 3 + kk;
            if (rl >= 0) {
                const u32x4* s = (const u32x4*)(C.P + (size_t)(b * T + rl) * NP + colP);
                const f32x4* wp = (const f32x4*)(C.ssm_conv_w + (size_t)kk * 1536 + ch);
#pragma unroll
                for (int j = 0; j < 4; ++j) { float xv[8]; unpack8(s[j], xv); const f32x4 w0 = wp[2 * j], w1 = wp[2 * j + 1];
#pragma unroll
                    for (int e = 0; e < 4; ++e) { acc[8 * j + e] += w0[e] * xv[e]; acc[8 * j + 4 + e] += w1[e] * xv[4 + e]; } }
            }
            asm volatile("" ::: "memory");
        }
#pragma unroll
        for (int x = 0; x < 32; ++x) acc[x] = silu_f(acc[x]);
        LAS bf16* dst = (tensor ? CS : BS) + l * 136 + n0;
#pragma unroll
        for (int j = 0; j < 4; ++j) { const u32x4 w = pack8f(acc + 8 * j); *(LAS u32x4*)(dst + 8 * j) = w;
            if (tensor && stf) *(u32x4*)(C.Cc + (size_t)(t0 + l) * 256 + gg * 128 + n0 + 8 * j) = w; }
        if (!tensor) {
#pragma unroll
            for (int x = 0; x < 32; ++x) BTS[(n0 + x) * 136 + l] = f2bf(acc[x]);
        }
    }
    __syncthreads();
    {
        bf16x8 cf[4];
#pragma unroll
        for (int ks = 0; ks < 4; ++ks) cf[ks] = *(const LAS bf16x8*)(CS + (16 * wv + r) * 136 + 32 * ks + 8 * q);
#pragma unroll
        for (int st = 0; st < 8; ++st) {
            f32x4 acc = (f32x4){0.f, 0.f, 0.f, 0.f};
#pragma unroll
            for (int ks = 0; ks < 4; ++ks) { const bf16x8 bfr = *(const LAS bf16x8*)(BS + (16 * st + r) * 136 + 32 * ks + 8 * q); acc = mfma16(bfr, cf[ks], acc); }
            if (stf) *(u32x2*)(C.CB + ((size_t)un2 * 128 + 16 * wv + r) * 128 + 16 * st + 4 * q) = pack4(acc);
        }
        for (int ch = tid; ch < 2048; ch += 512) { const int n = ch >> 4, part = ch & 15;
            const u32x4 bv_ = *(const LAS u32x4*)(BTS + n * 136 + part * 8); if (stf) *(u32x4*)(C.BT + ((size_t)un2 * 128 + n) * 128 + part * 8) = bv_; }
    }
    __syncthreads();
}

template <int NE>
__device__ __forceinline__ void gdn_scan(const Ctx& C, int bh, int eb, bool st = true) {
    const int tid = C.tid, lane = C.lane, wv = C.wave, r = lane & 15, q = lane >> 4;
    const int b = bh >> 3, h = bh & 7, e0 = 16 * NE * eb;
    LAS bf16* ST = (LAS bf16*)(C.lds + 0);
    LAS bf16* VNT = (LAS bf16*)(C.lds + 16 * NE * 136 * 2);
    for (int idx = tid; idx < (16 * NE * (136 + 72) * 2) / 4; idx += 512) ((LAS unsigned*)C.lds)[idx] = 0u;
    f32x4 S[NE];
#pragma unroll
    for (int et = 0; et < NE; ++et) S[et] = (f32x4){0.f, 0.f, 0.f, 0.f};
    const int mt = wv & 3; const bool lead = wv < 4;
    const size_t rowA = ((size_t)b * T + 16 * mt + r) * NP + (lead ? PK : PQ) + h * 128 + 8 * q;
    const size_t rowU = ((size_t)b * T + 16 * mt + r) * NP + PV + h * 128 + e0 + 4 * q;
    const size_t offT = ((size_t)bh * 128 * 64 + 16 * mt + r) * 64 + 8 * q;
    const size_t offK = ((size_t)bh * 128 * 128 + 16 * wv + r) * 64 + 8 * q;
#define GS_DECL(k) bf16x8 af0_##k, af1_##k, af2_##k, af3_##k, at0_##k = {0,0,0,0,0,0,0,0}, at1_##k = {0,0,0,0,0,0,0,0}, kf0_##k, kf1_##k; u32x2 u_##k[NE]; float cd_##k;
#define GS_LOAD(k, cc) do { const size_t _c = (size_t)((cc) < 127 ? (cc) : 127); const bf16* _a = C.P + rowA + _c * 64 * NP; \
        af0_##k = *(const bf16x8*)(_a); af1_##k = *(const bf16x8*)(_a + 32); af2_##k = *(const bf16x8*)(_a + 64); af3_##k = *(const bf16x8*)(_a + 96); \
        _Pragma("unroll") for (int et = 0; et < NE; ++et) u_##k[et] = *(const u32x2*)(C.P + rowU + _c * 64 * NP + 16 * et); \
        at0_##k = *(const bf16x8*)(C.attn + offT + _c * 4096); at1_##k = *(const bf16x8*)(C.attn + offT + _c * 4096 + 32); \
        kf0_##k = *(const bf16x8*)(C.kdT + offK + _c * 8192); kf1_##k = *(const bf16x8*)(C.kdT + offK + _c * 8192 + 32); \
        cd_##k = C.cdv[bh * 128 + (int)_c]; } while (0)
#define GS_STEP(k, cc) do { \
        f32x4 acc[NE]; \
        _Pragma("unroll") for (int et = 0; et < NE; ++et) { const LAS bf16* sp = ST + (16 * et + r) * 136 + 8 * q; f32x4 a_ = (f32x4){0.f, 0.f, 0.f, 0.f}; \
          a_ = mfma16(*(const LAS bf16x8*)(sp), af0_##k, a_); a_ = mfma16(*(const LAS bf16x8*)(sp + 32), af1_##k, a_); \
          a_ = mfma16(*(const LAS bf16x8*)(sp + 64), af2_##k, a_); a_ = mfma16(*(const LAS bf16x8*)(sp + 96), af3_##k, a_); acc[et] = a_; }        \
        if (lead) { _Pragma("unroll") for (int et = 0; et < NE; ++et) { const u32x2 uu = u_##k[et]; const float u4[4] = {bflo(uu.x), bfhi(uu.x), bflo(uu.y), bfhi(uu.y)}; \
            LAS bf16* vp = VNT + (16 * et + 4 * q) * 72 + 16 * mt + r; \
            _Pragma("unroll") for (int t = 0; t < 4; ++t) vp[t * 72] = f2bf(u4[t] - acc[et][t]); } } \
        __syncthreads(); \
        _Pragma("unroll") for (int et = 0; et < NE; ++et) { \
            const bf16x8 vf0 = *(const LAS bf16x8*)(VNT + (16 * et + r) * 72 + 8 * q), vf1 = *(const LAS bf16x8*)(VNT + (16 * et + r) * 72 + 32 + 8 * q); \
            if (!lead) { f32x4 a_ = acc[et]; a_ = mfma16(vf0, at0_##k, a_); a_ = mfma16(vf1, at1_##k, a_); \
                if (st) *(u32x2*)(C.P + rowU + (size_t)(cc) * 64 * NP + 16 * et) = pack4(a_); }                    \
            f32x4 s_ = S[et] * cd_##k; \
            s_ = mfma16(kf0_##k, vf0, s_); s_ = mfma16(kf1_##k, vf1, s_); S[et] = s_;                             \
            *(LAS u32x2*)(ST + (16 * et + r) * 136 + 16 * wv + 4 * q) = pack4(s_); } \
        GS_LOAD(k, (cc) + 3); \
        __syncthreads(); } while (0)
    GS_DECL(0) GS_DECL(1) GS_DECL(2)
    GS_LOAD(0, 0); asm volatile("" ::: "memory"); GS_LOAD(1, 1); asm volatile("" ::: "memory"); GS_LOAD(2, 2); asm volatile("" ::: "memory");
    __syncthreads();
    for (int c = 0; c < 126; c += 3) { GS_STEP(0, c); GS_STEP(1, c + 1); GS_STEP(2, c + 2); }
    GS_STEP(0, 126); GS_STEP(1, 127);
#undef GS_DECL
#undef GS_LOAD
#undef GS_STEP
}
__device__ __forceinline__ void ssd_scan(const Ctx& C, int b, int hh, int pq, bool st = true) {
    const int tid = C.tid, lane = C.lane, wv = C.wave, r = lane & 15, q = lane >> 4;
    const int gg = hh >> 3, p0 = 16 * pq, l = 16 * wv + r, pc = p0 + 4 * q;
    LAS bf16* XDT = (LAS bf16*)(C.lds + 0);
    LAS bf16* XDS = (LAS bf16*)(C.lds + 4352);
    LAS bf16* HP = (LAS bf16*)(C.lds + 8704);
    LAS float* ACS = (LAS float*)(C.lds + 13056);
    LAS float* DTV = (LAS float*)(C.lds + 14080);
    LAS bf16* XH = (LAS bf16*)(C.lds + 15104);
    for (int idx = tid; idx < 4352 / 4; idx += 512) ((LAS unsigned*)(C.lds + 8704))[idx] = 0u;
    for (int idx = tid; idx < 192 / 4; idx += 512) ((LAS unsigned*)(C.lds + 15104))[idx] = 0u;
    f32x4 H = (f32x4){0.f, 0.f, 0.f, 0.f};
    const float Aneg = -expf(C.ssm_a_log[hh]), dtb = C.ssm_dt_bias[hh], Dsk = C.ssm_d[hh];
    f32x4 cw[4]; const f32x4 cbias = *(const f32x4*)(C.ssm_conv_b + hh * 64 + pc);
#pragma unroll
    for (int kk = 0; kk < 4; ++kk) cw[kk] = *(const f32x4*)(C.ssm_conv_w + (size_t)kk * 1536 + hh * 64 + pc);
    const size_t rowX = ((size_t)b * T + l) * NP + PXS + hh * 64 + pc;
    const size_t rowZ = ((size_t)b * T + l) * NP + PZS + hh * 64 + pc;
    const size_t offCB = (((size_t)b * 64) * 2 + gg) * 128 * 128 + (size_t)l * 128 + 8 * q;
    const size_t offCc = ((size_t)b * T + l) * 256 + gg * 128 + 8 * q;
    const size_t offDt = ((size_t)b * T + 2 * lane) * 32 + 16 + hh;
#define SS_DECL(k) u32x2 x0_##k, x1_##k, x2_##k, x3_##k, z_##k; bf16x8 cb0_##k, cb1_##k, cb2_##k, cb3_##k, cc0_##k, cc1_##k, cc2_##k, cc3_##k, bt0_##k, bt1_##k, bt2_##k, bt3_##k; float d0_##k = 0.f, d1_##k = 0.f;
#define SS_LOAD(k, cc) do { const size_t _c = (size_t)((cc) < 63 ? (cc) : 63); const bf16* _x = C.P + rowX + _c * 128 * NP; \
        d0_##k = C.small[offDt + _c * 4096]; d1_##k = C.small[offDt + _c * 4096 + 32]; \
        x3_##k = *(const u32x2*)(_x); \
        x2_##k = (l >= 1) ? *(const u32x2*)(_x - NP) : (u32x2){0u, 0u}; x1_##k = (l >= 2) ? *(const u32x2*)(_x - 2 * NP) : (u32x2){0u, 0u}; x0_##k = (l >= 3) ? *(const u32x2*)(_x - 3 * NP) : (u32x2){0u, 0u}; \
        z_##k = *(const u32x2*)(C.P + rowZ + _c * 128 * NP); \
        const bf16* _cb = C.CB + offCB + _c * 32768; cb0_##k = *(const bf16x8*)(_cb); cb1_##k = *(const bf16x8*)(_cb + 32); cb2_##k = *(const bf16x8*)(_cb + 64); cb3_##k = *(const bf16x8*)(_cb + 96); \
        const bf16* _bt = C.BT + offCB + _c * 32768; bt0_##k = *(const bf16x8*)(_bt); bt1_##k = *(const bf16x8*)(_bt + 32); bt2_##k = *(const bf16x8*)(_bt + 64); bt3_##k = *(const bf16x8*)(_bt + 96); \
        const bf16* _cc = C.Cc + offCc + _c * 32768; cc0_##k = *(const bf16x8*)(_cc); cc1_##k = *(const bf16x8*)(_cc + 32); cc2_##k = *(const bf16x8*)(_cc + 64); cc3_##k = *(const bf16x8*)(_cc + 96); \
        } while (0)
#define SS_CUMSUM(k, buf) do { const float _dt0 = softplus_f(d0_##k + dtb), _dt1 = softplus_f(d1_##k + dtb); const float _a0 = _dt0 * Aneg, _a1 = _dt1 * Aneg; float _s = _a0 + _a1; const float _own = _s; \
        _Pragma("unroll") for (int _o = 1; _o < 64; _o <<= 1) { const float _v2 = __shfl_up(_s, _o); if (lane >= _o) _s += _v2; } \
        const float _ex = _s - _own; LAS float* _A = ACS + (buf) * 128 + 2 * lane; LAS float* _D = DTV + (buf) * 128 + 2 * lane; _A[0] = _ex + _a0; _A[1] = _ex + _a0 + _a1; _D[0] = _dt0; _D[1] = _dt1; } while (0)
#define SS_STEP(k, kn, cc) do { const int pb = (k); \
        u32x2 x0 = x0_##k, x1 = x1_##k, x2 = x2_##k; const u32x2 x3 = x3_##k; \
        if (l < 3) { const LAS bf16* xh = XH + (pb ^ 1) * 48 + 4 * q; \
            if (l < 1) x2 = *(const LAS u32x2*)(xh + 2 * 16); if (l < 2) x1 = *(const LAS u32x2*)(xh + (1 + l) * 16); x0 = *(const LAS u32x2*)(xh + l * 16); } \
        float xs[4]; \
        { const float a0[4] = {bflo(x0.x), bfhi(x0.x), bflo(x0.y), bfhi(x0.y)}, a1[4] = {bflo(x1.x), bfhi(x1.x), bflo(x1.y), bfhi(x1.y)}; \
          const float a2[4] = {bflo(x2.x), bfhi(x2.x), bflo(x2.y), bfhi(x2.y)}, a3[4] = {bflo(x3.x), bfhi(x3.x), bflo(x3.y), bfhi(x3.y)}; \
          _Pragma("unroll") for (int t = 0; t < 4; ++t) xs[t] = silu_f(cbias[t] + cw[0][t] * a0[t] + cw[1][t] * a1[t] + cw[2][t] * a2[t] + cw[3][t] * a3[t]); } \
        const float al = ACS[pb * 128 + l], alast = ACS[pb * 128 + 127]; \
        { const float dtl = DTV[pb * 128 + l], ed = expf(alast - al); \
          LAS bf16* xt = XDT + (4 * q) * 136 + l; LAS bf16* xd = XDS + (4 * q) * 136 + l; \
          _Pragma("unroll") for (int t = 0; t < 4; ++t) { const float v = xs[t] * dtl; xt[t * 136] = f2bf(v); xd[t * 136] = f2bf(v * ed); } \
          if (l >= 125) *(LAS u32x2*)(XH + pb * 48 + (l - 125) * 16 + 4 * q) = x3; } \
        __syncthreads(); \
        { const LAS float* acs = ACS + pb * 128; \
          bf16x8 sf[4]; \
          _Pragma("unroll") for (int ks = 0; ks < 4; ++ks) { \
              const bf16x8 cbk = ks == 0 ? cb0_##k : (ks == 1 ? cb1_##k : (ks == 2 ? cb2_##k : cb3_##k)); \
              float cbv[8]; unpack8(__builtin_bit_cast(u32x4, cbk), cbv); \
              const f32x4 s0 = *(const LAS f32x4*)(acs + 32 * ks + 8 * q), s1 = *(const LAS f32x4*)(acs + 32 * ks + 8 * q + 4); \
              _Pragma("unroll") for (int x = 0; x < 8; ++x) { const int s = 32 * ks + 8 * q + x; const float as = x < 4 ? s0[x & 3] : s1[x & 3]; cbv[x] = (s <= l) ? cbv[x] * expf(al - as) : 0.f; } \
              sf[ks] = __builtin_bit_cast(bf16x8, pack8f(cbv)); } \
          f32x4 yd = (f32x4){0.f, 0.f, 0.f, 0.f}, yo = yd, Hn = yd; \
          const LAS bf16* xp = XDT + r * 136 + 8 * q; const LAS bf16* hp = HP + r * 136 + 8 * q; const LAS bf16* dp = XDS + r * 136 + 8 * q; \
          yd = mfma16(*(const LAS bf16x8*)(xp), sf[0], yd); yd = mfma16(*(const LAS bf16x8*)(xp + 32), sf[1], yd); yd = mfma16(*(const LAS bf16x8*)(xp + 64), sf[2], yd); yd = mfma16(*(const LAS bf16x8*)(xp + 96), sf[3], yd); \
          yo = mfma16(*(const LAS bf16x8*)(hp), cc0_##k, yo); yo = mfma16(*(const LAS bf16x8*)(hp + 32), cc1_##k, yo); yo = mfma16(*(const LAS bf16x8*)(hp + 64), cc2_##k, yo); yo = mfma16(*(const LAS bf16x8*)(hp + 96), cc3_##k, yo); \
          Hn = mfma16(bt0_##k, *(const LAS bf16x8*)(dp), Hn); Hn = mfma16(bt1_##k, *(const LAS bf16x8*)(dp + 32), Hn); Hn = mfma16(bt2_##k, *(const LAS bf16x8*)(dp + 64), Hn); Hn = mfma16(bt3_##k, *(const LAS bf16x8*)(dp + 96), Hn); \
          const float eal = expf(al); \
          const float z4[4] = {bflo(z_##k.x), bfhi(z_##k.x), bflo(z_##k.y), bfhi(z_##k.y)}; \
          f32x4 o; \
          _Pragma("unroll") for (int t = 0; t < 4; ++t) { const float y = yd[t] + eal * yo[t] + xs[t] * Dsk; o[t] = y * silu_f(z4[t]); } \
          if (st) *(u32x2*)(C.P + rowX + (size_t)(cc) * 128 * NP) = pack4(o); \
          H = H * expf(alast) + Hn; \
          if (wv == 7) SS_CUMSUM(kn, pb ^ 1); } \
        SS_LOAD(k, (cc) + 2); \
        __syncthreads(); \
        *(LAS u32x2*)(HP + r * 136 + 16 * wv + 4 * q) = pack4(H); } while (0)
    SS_DECL(0) SS_DECL(1)
    SS_LOAD(0, 0); asm volatile("" ::: "memory"); if (wv == 7) SS_CUMSUM(0, 0);
    asm volatile("" ::: "memory"); SS_LOAD(1, 1); asm volatile("" ::: "memory");
    __syncthreads();
    for (int c = 0; c < 64; c += 2) { SS_STEP(0, 1, c); SS_STEP(1, 0, c + 1); }
    __syncthreads();
#undef SS_DECL
#undef SS_LOAD
#undef SS_CUMSUM
#undef SS_STEP
}

__device__ __forceinline__ void p4_finish(const Ctx& C) {
    const int gw = C.vcu * NWAVES + C.wave, NGW = C.G * NWAVES, lane = C.lane, c0 = 16 * lane;
    for (int m = gw; m < M; m += NGW) {
        const bf16* prow = C.P + (size_t)m * NP;
        {
            float o[16], z[16]; const u32x4* op = (const u32x4*)(prow + PV + c0); const u32x4* zp = (const u32x4*)(prow + PZG + c0);
            unpack8(op[0], o); unpack8(op[1], o + 8); unpack8(zp[0], z); unpack8(zp[1], z + 8);
            float ss = 0.f;
#pragma unroll
            for (int x = 0; x < 16; ++x) ss += o[x] * o[x];
            ss += __shfl_xor(ss, 1); ss += __shfl_xor(ss, 2); ss += __shfl_xor(ss, 4);
            const float rs = rsqrtf(ss * (1.f / 128.f) + EPS);
            const f32x4* nw = (const f32x4*)(C.gdn_norm_w + (c0 & 127));
#pragma unroll
            for (int j = 0; j < 4; ++j) { const f32x4 w = nw[j];
#pragma unroll
                for (int e = 0; e < 4; ++e) o[4 * j + e] = o[4 * j + e] * rs * w[e] * silu_f(z[4 * j + e]); }
            u32x4* mp = (u32x4*)(C.mix + (size_t)m * MIXD + c0); mp[0] = pack8f(o); mp[1] = pack8f(o + 8);
        }
        {
            float y[16]; const u32x4* yp = (const u32x4*)(prow + PXS + c0); unpack8(yp[0], y); unpack8(yp[1], y + 8);
            float ss = 0.f;
#pragma unroll
            for (int x = 0; x < 16; ++x) ss += y[x] * y[x];
            ss += __shfl_xor(ss, 1); ss += __shfl_xor(ss, 2); ss += __shfl_xor(ss, 4); ss += __shfl_xor(ss, 8); ss += __shfl_xor(ss, 16);
            const float rs = rsqrtf(ss * (1.f / 512.f) + EPS);
            const f32x4* nw = (const f32x4*)(C.ssm_norm_w + c0);
#pragma unroll
            for (int j = 0; j < 4; ++j) { const f32x4 w = nw[j];
#pragma unroll
                for (int e = 0; e < 4; ++e) y[4 * j + e] = y[4 * j + e] * rs * w[e]; }
            u32x4* mp = (u32x4*)(C.mix + (size_t)m * MIXD + 1024 + c0); mp[0] = pack8f(y); mp[1] = pack8f(y + 8);
        }
    }
}

__device__ __forceinline__ void attn_unit(const Ctx& C, int un) {
    const int wv = C.wave;
    const int pm = un >> 2, hd = un & 3, b = pm >> 5;
    const size_t tq0 = (size_t)pm * 256 + 32 * wv;
    LAS bf16* PS = (LAS bf16*)(C.lds + wv * 16896);
    const char* Kb = (const char*)(C.Kmem + (size_t)b * 256 * 1024 + hd * 256);
    const char* Vb = (const char*)(C.VT + ((size_t)b * 1024 + hd * 256) * 256);
    const char* Qb = (const char*)(C.qb + tq0 * 1024 + hd * 256);
    char* Ob = (char*)(C.ao + tq0 * 1024 + hd * 256);
#pragma unroll 1
    for (int it = 0; it < 2; ++it) {
        const int lane = opaque(C.lane), r = lane & 15, q = lane >> 4;
        bf16x8 qf[8];
        const unsigned qoff = (unsigned)((16 * it + r) * 1024 + 8 * q) * 2u;
#pragma unroll
        for (int ks = 0; ks < 8; ++ks) qf[ks] = *(const bf16x8*)(Qb + qoff + 64 * ks);
        const unsigned koff = (unsigned)(r * 1024 + 8 * q) * 2u;
        f32x4 sc[16];
#pragma unroll
        for (int mt = 0; mt < 16; ++mt) {
            f32x4 acc = (f32x4){0.f, 0.f, 0.f, 0.f};
#pragma unroll
            for (int ks = 0; ks < 8; ++ks) acc = mfma16(*(const bf16x8*)(Kb + (koff + (unsigned)(mt * 32768 + 64 * ks))), qf[ks], acc);
            sc[mt] = acc;
            if (mt & 1) asm volatile("" ::: "memory");
        }
        float mx = -3.0e38f;
#pragma unroll
        for (int mt = 0; mt < 16; ++mt) mx = fmaxf(fmaxf(fmaxf(sc[mt][0], sc[mt][1]), fmaxf(sc[mt][2], sc[mt][3])), mx);
        mx = fmaxf(mx, __shfl_xor(mx, 16)); mx = fmaxf(mx, __shfl_xor(mx, 32));
        float sum = 0.f;
#pragma unroll
        for (int mt = 0; mt < 16; ++mt)
#pragma unroll
            for (int t = 0; t < 4; ++t) { const float e = __expf(sc[mt][t] - mx); sc[mt][t] = e; sum += e; }
        sum += __shfl_xor(sum, 16); sum += __shfl_xor(sum, 32);
        const float inv = 1.f / sum;
        LAS bf16* prow = PS + (16 * it + r) * 264 + 4 * q;
#pragma unroll
        for (int mt = 0; mt < 16; ++mt) *(LAS u32x2*)(prow + 16 * mt) = pack4(sc[mt] * inv);
    }
    LDS_WAIT(); asm volatile("" ::: "memory");
#pragma unroll 1
    for (int it = 0; it < 2; ++it) {
        const int lane = opaque(C.lane), r = lane & 15, q = lane >> 4;
        bf16x8 pf[8];
        const LAS bf16* prow = PS + (16 * it + r) * 264 + 8 * q;
#pragma unroll
        for (int ks = 0; ks < 8; ++ks) pf[ks] = *(const LAS bf16x8*)(prow + 32 * ks);
        const unsigned voff = (unsigned)(r * 256 + 8 * q) * 2u;
        const unsigned ooff = (unsigned)((16 * it + r) * 1024 + 4 * q) * 2u;
#pragma unroll
        for (int dt = 0; dt < 16; ++dt) {
            f32x4 acc = (f32x4){0.f, 0.f, 0.f, 0.f};
#pragma unroll
            for (int ks = 0; ks < 8; ++ks) acc = mfma16(*(const bf16x8*)(Vb + (voff + (unsigned)(dt * 8192 + 64 * ks))), pf[ks], acc);
            *(u32x2*)(Ob + (ooff + (unsigned)(dt * 32))) = pack4(acc);
            if (dt & 1) asm volatile("" ::: "memory");
        }
    }
}

__device__ __forceinline__ void p11_final(const Ctx& C) {
    const int gw = C.vcu * NWAVES + C.wave, NGW = C.G * NWAVES, lane = C.lane;
    for (int m = gw; m < M; m += NGW) {
        f32x4* xr = (f32x4*)(C.out + (size_t)m * D) + lane; const f32x4* wr = (const f32x4*)C.final_norm_w + lane;
        f32x4 v[4]; float s = 0.f;
#pragma unroll
        for (int j = 0; j < 4; ++j) { v[j] = xr[64 * j]; s += (v[j][0] * v[j][0] + v[j][1] * v[j][1]) + (v[j][2] * v[j][2] + v[j][3] * v[j][3]); }
        const float rstd = rsqrtf(wave_sum(s) * (1.f / 1024.f) + EPS);
#pragma unroll
        for (int j = 0; j < 4; ++j) xr[64 * j] = v[j] * rstd * wr[64 * j];
    }
}


#ifdef DBG_CK
__device__ __forceinline__ float ck_sum(const bf16* p, size_t n16, int gw, int NGW, int lane) {
    float s = 0.f;
    for (size_t i = (size_t)gw * 64 + lane; i < n16; i += (size_t)NGW * 64) { float v[8]; unpack8(((const u32x4*)p)[i], v);
#pragma unroll
        for (int x = 0; x < 8; ++x) s += fabsf(v[x]) < 1e30f ? fabsf(v[x]) : 777.f; }
    return wave_sum(s);
}
__device__ __forceinline__ void dbg_ck_a(const Ctx& C) {
    const int gw = C.vcu * NWAVES + C.wave, NGW = C.G * NWAVES, lane = C.lane;
    float* ck = (float*)(C.ws + 255 * MiB + 512 * 1024);
    float r[8];
    r[0] = ck_sum(C.attn, (size_t)16 * MiB / 16, gw, NGW, lane);
    r[1] = ck_sum(C.kdT, (size_t)32 * MiB / 16, gw, NGW, lane);
    r[2] = ck_sum(C.BT, (size_t)8 * MiB / 16, gw, NGW, lane);
    r[3] = ck_sum(C.Cc, (size_t)8 * MiB / 16, gw, NGW, lane);
    r[4] = ck_sum(C.CB, (size_t)8 * MiB / 16, gw, NGW, lane);
    r[5] = C.cdv[gw]; r[6] = 0.f; r[7] = 0.f;
    if (lane < 8) { float v = 0.f;
#pragma unroll
        for (int x = 0; x < 8; ++x) if (lane == x) v = ((DBG_CK >> x) & 1) ? r[x] : 0.f;
        ck[gw * 8 + lane] = v; }
}
__device__ __forceinline__ void dbg_ck_b(const Ctx& C) {
    const float* ck = (const float*)(C.ws + 255 * MiB + 512 * 1024);
    for (size_t i = (size_t)C.bx * 512 + C.tid; i < (size_t)M * D; i += (size_t)C.G * 512) C.out[i] = ck[i & 16383];
}
#endif
#ifdef DBG_PHASE
__device__ __forceinline__ void dbg_digest(const Ctx& C) {
    const int gw = C.vcu * NWAVES + C.wave, NGW = C.G * NWAVES, lane = C.lane;
    for (int m = gw; m < M; m += NGW) {
        float acc[16];
#pragma unroll
        for (int x = 0; x < 16; ++x) acc[x] = 0.f;
        const int c0 = 16 * lane;
        if (DBG_PHASE <= 3) {
            const bf16* prow = C.P + (size_t)m * NP;
#pragma unroll
            for (int sct = 0; sct < 6; ++sct) { if (!((DBG_SEL >> sct) & 1)) continue; float v[16]; const u32x4* p = (const u32x4*)(prow + sct * 1024 + c0); unpack8(p[0], v); unpack8(p[1], v + 8);
#pragma unroll
                for (int x = 0; x < 16; ++x) acc[x] += v[x]; }
            if (lane < 32 && ((DBG_SEL >> 6) & 1)) { float v[16]; const u32x4* p = (const u32x4*)(prow + 6144 + c0); unpack8(p[0], v); unpack8(p[1], v + 8);
#pragma unroll
                for (int x = 0; x < 16; ++x) acc[x] += v[x]; }
            if (DBG_PHASE <= 2) {
#pragma unroll
                for (int x = 0; x < 16; ++x) acc[x] += C.small[(size_t)m * 32 + ((c0 + x) & 31)]; }
            else {
#pragma unroll
                for (int x = 0; x < 16; ++x) if ((DBG_SEL >> 7) & 1) acc[x] += C.ssm_ss[(size_t)m * 16 + x] * 1e-3f; }
        } else if (DBG_PHASE == 4) {
#pragma unroll
            for (int sct = 0; sct < 2; ++sct) { float v[16]; const u32x4* p = (const u32x4*)(C.mix + (size_t)m * MIXD + sct * 1024 + c0); unpack8(p[0], v); unpack8(p[1], v + 8);
#pragma unroll
                for (int x = 0; x < 16; ++x) acc[x] += v[x]; }
        } else if (DBG_PHASE == 5 || DBG_PHASE == 8) {
#pragma unroll
            for (int x = 0; x < 16; ++x) acc[x] = C.x1[(size_t)m * D + c0 + x];
        } else if (DBG_PHASE == 6 || DBG_PHASE == 7) {
            float v[16]; const u32x4* p = (const u32x4*)((DBG_PHASE == 6 ? C.qb : C.ao) + (size_t)m * D + c0); unpack8(p[0], v); unpack8(p[1], v + 8);
#pragma unroll
            for (int x = 0; x < 16; ++x) acc[x] = v[x];
        } else if (DBG_PHASE == 9) {
#pragma unroll
            for (int sct = 0; sct < 4; ++sct) { float v[16]; const u32x4* p = (const u32x4*)(C.hb + (size_t)m * FF + sct * 1024 + c0); unpack8(p[0], v); unpack8(p[1], v + 8);
#pragma unroll
                for (int x = 0; x < 16; ++x) acc[x] += v[x]; }
        }
        asm volatile("s_waitcnt vmcnt(0)" ::: "memory");
        float* orow = C.out + (size_t)m * D + c0;
#pragma unroll
        for (int x = 0; x < 16; ++x) orow[x] = (fabsf(acc[x]) < 1e30f) ? acc[x] : 12345.f;
    }
}
#endif

#ifndef MK_N_LAUNCHES
#define MK_N_LAUNCHES 1
#endif
constexpr int N_PHASES = 12;
#ifndef GDN_NE
#define GDN_NE 4
#endif
constexpr int N_LAUNCHES = MK_N_LAUNCHES;
struct Args { const float* in[25]; float* out; unsigned char* ws; int ph_lo, ph_hi; };
__global__ void __launch_bounds__(NWAVES * 64, 2) fwd_kernel(Args args) {
    extern __shared__ __attribute__((aligned(16))) unsigned char lds[];
    Ctx C;
    C.lds = (LAS unsigned char*)lds;
    C.tid = threadIdx.x; C.lane = C.tid & 63; C.wave = __builtin_amdgcn_readfirstlane(C.tid >> 6);
    C.G = gridDim.x; C.bx = blockIdx.x; C.vcu = (C.G % 8 == 0) ? (C.bx % 8) * (C.G / 8) + C.bx / 8 : C.bx;
    C.x = args.in[0]; C.mem = args.in[1]; C.norm1_w = args.in[2]; C.w_in = args.in[3]; C.gdn_conv_w = args.in[4]; C.gdn_a_log = args.in[5]; C.gdn_dt_bias = args.in[6]; C.gdn_norm_w = args.in[7];
    C.ssm_conv_w = args.in[8]; C.ssm_conv_b = args.in[9]; C.ssm_a_log = args.in[10]; C.ssm_dt_bias = args.in[11]; C.ssm_d = args.in[12]; C.ssm_norm_w = args.in[13]; C.w_out = args.in[14];
    C.norm2_w = args.in[15]; C.mem_norm_w = args.in[16]; C.wq = args.in[17]; C.wk = args.in[18]; C.wv = args.in[19]; C.wo = args.in[20]; C.norm3_w = args.in[21]; C.w_up = args.in[22];
    C.w_down = args.in[23]; C.final_norm_w = args.in[24];
    C.out = args.out; C.ws = args.ws; C.dob = (unsigned char*)args.out;
    unsigned char* ws = args.ws; unsigned char* dob = C.dob;
    C.P = (bf16*)(ws + WS_P); C.Win_t = (bf16*)(ws + WS_WIN); C.Wkv_t = (bf16*)(ws + WS_WKV); C.Wout_t = (bf16*)(ws + WS_WOUT); C.Wq_t = (bf16*)(ws + WS_WQ); C.Wo_t = (bf16*)(ws + WS_WO);
    C.Wup_t = (bf16*)(ws + WS_WUP); C.Wdn_t = (bf16*)(ws + WS_WDN); C.Kmem = (bf16*)(ws + WS_KMEM); C.VT = (bf16*)(ws + WS_VT); C.MN = (bf16*)(ws + WS_MN);
    C.XN1 = (bf16*)(dob + DO_XN1); C.halo = (bf16*)(dob + DO_HALO); C.kdT = (bf16*)(dob + DO_KDT); C.attn = (bf16*)(dob + DO_ATTN); C.BT = (bf16*)(dob + DO_BT);
    C.Cc = (bf16*)(ws + WS_CC); C.CB = (bf16*)(ws + WS_CB); C.mix = (bf16*)dob; C.x1b = (bf16*)(ws + WS_X1B); C.qb = (bf16*)(ws + WS_Q); C.ao = (bf16*)(ws + WS_AO); C.hb = (bf16*)(ws + WS_HB);
    C.small = (float*)(ws + WS_SMALL); C.cdv = (float*)(ws + WS_CDV); C.ssm_ss = (float*)(ws + WS_MN); C.ssp = (float*)(ws + WS_SMALL); C.x1 = (float*)(ws + WS_X1);
    for (int u = C.tid; u < (LDS_BYTES - MISC_OFF) / 4; u += NWAVES * 64) ((LAS unsigned*)(C.lds + MISC_OFF))[u] = 0u;
    __syncthreads();
    XcdBarrier bar; bar.bar = (unsigned*)(ws + WS_CTL) + CW_BAR; bar.x = 0; bar.st = nullptr;
    if (N_LAUNCHES == 1) bar = xcd_barrier_post((unsigned*)(ws + WS_CTL) + CW_BAR, (volatile LAS unsigned*)(C.lds + MISC_OFF) + 8);
    const int lo = args.ph_lo, hi = args.ph_hi;
#ifndef PH_MASK
#define PH_MASK 0xFFF
#endif
#define IN(k) (((PH_MASK >> (k)) & 1) && lo <= (k) && (k) < hi)
#ifndef REP_MASK
#define REP_MASK 0
#endif
#define NREP(k) (((REP_MASK >> (k)) & 1) ? 2 : 1)
#define SEAM(k) do { if (IN(k) && IN((k) + 1)) xcd_barrier(bar); } while (0)
    LAS unsigned char* ring = (LAS unsigned char*)lds;
#ifdef PROBE_A
#define STAMP(k) do { if (C.bx == 0 && C.tid == 0) ((volatile LAS unsigned long long*)(C.lds + MISC_OFF + 64))[k] = __builtin_amdgcn_s_memrealtime(); } while (0)
#undef SEAM
#define SEAM(k) do { if (IN(k) && IN((k) + 1)) xcd_barrier(bar); STAMP((k) + 1); } while (0)
    STAMP(0);
#endif

    if (IN(0)) { for (int rep = 0; rep < NREP(0); ++rep) p0_prologue(C); } SEAM(0);
    if (IN(1)) for (int rep = 0; rep < NREP(1); ++rep) {
        { pg8::Gemm g{C.XN1, C.Win_t, M, NIN, D}; pg8::StaticOrder S; S.init(M, NIN, C.G, C.bx);
          pg8::EpiIn E{C.P, C.small, C.halo};
          pg8::gemm_phase<pg8::EpiIn, pg8::StaticOrder, true, true>(ring, g, S, E); }
        __syncthreads();
        { pg8::Gemm g{C.MN, C.Wkv_t, BATCH * MEMLEN, 2048, D}; pg8::StaticOrder S; S.init(BATCH * MEMLEN, 2048, C.G, C.G - 1 - C.bx);
          pg8::EpiKV E{C.Kmem, C.VT};
          pg8::gemm_phase<pg8::EpiKV, pg8::StaticOrder, true, true>(ring, g, S, E); }
    } SEAM(1);
    if (IN(2)) {
        for (int rep = 0; rep < NREP(2); ++rep) { const bool stf = (rep == NREP(2) - 1) || (hi < 0);
        for (int un = C.vcu; un < 2048; un += C.G) gdn_prep_unit(C, un, stf);
        for (int un2 = C.vcu; un2 < 256; un2 += C.G) ssd_prep_unit(C, un2, stf); }
    } SEAM(2);
    if (IN(3)) {
        for (int rep = 0; rep < NREP(3); ++rep) { const bool stf = (rep == NREP(3) - 1) || (hi < 0);
        constexpr int NE = GDN_NE, NGW = 128 / NE;
        if (C.bx < NGW) { const int xx = C.bx & 7, yy = C.bx >> 3;
#ifdef DRY_GDN
            gdn_scan<NE>(C, xx + 8 * (yy / (8 / NE)), yy % (8 / NE), hi < 0); __syncthreads();
#endif
            gdn_scan<NE>(C, xx + 8 * (yy / (8 / NE)), yy % (8 / NE), stf); }
        else if (C.bx < NGW + 128) { const int s = C.bx - NGW, combo = s & 3, idx = s >> 2;
#ifdef DRY_SSD
            ssd_scan(C, combo >> 1, (combo & 1) * 8 + (idx >> 2), idx & 3, hi < 0); __syncthreads();
#endif
            ssd_scan(C, combo >> 1, (combo & 1) * 8 + (idx >> 2), idx & 3, stf); }
        __syncthreads(); }
    } SEAM(3);
    if (IN(4)) { for (int rep = 0; rep < NREP(4); ++rep) p4_finish(C); } SEAM(4);
    if (IN(5)) for (int rep = 0; rep < NREP(5); ++rep) {
        pg8::Gemm g{C.mix, C.Wout_t, M, D, MIXD}; pg8::StaticOrder S; S.init(M, D, C.G, C.bx);
        pg8::EpiRes E{C.x, C.x1, C.x1b, C.ssp};
        pg8::gemm_phase<pg8::EpiRes, pg8::StaticOrder, true, true>(ring, g, S, E);
    } SEAM(5);
    if (IN(6)) for (int rep = 0; rep < NREP(6); ++rep) {
        pg8::Gemm g{C.x1b, C.Wq_t, M, D, D}; pg8::StaticOrder S; S.init(M, D, C.G, C.bx);
        pg8::EpiScale<0> E{C.qb, D, C.ssp, 0.0625f};
        pg8::gemm_phase<pg8::EpiScale<0>, pg8::StaticOrder, true, true>(ring, g, S, E);
    } SEAM(6);
    if (IN(7)) { for (int rep = 0; rep < NREP(7); ++rep) for (int un = C.vcu; un < 256; un += C.G) attn_unit(C, un); __syncthreads(); } SEAM(7);
    if (IN(8)) {
        pg8::Gemm g{C.ao, C.Wo_t, M, D, D}; pg8::StaticOrder S; S.init(M, D, C.G, C.bx);
        pg8::EpiRes E{C.x1, C.x1, C.x1b, C.ssp};
        pg8::gemm_phase<pg8::EpiRes, pg8::StaticOrder, true, true>(ring, g, S, E);
    } SEAM(8);
    if (IN(9)) for (int rep = 0; rep < NREP(9); ++rep) {
        pg8::Gemm g{C.x1b, C.Wup_t, M, FF, D}; pg8::StaticOrder S; S.init(M, FF, C.G, C.bx);
        pg8::EpiScale<1> E{C.hb, FF, C.ssp, 1.0f};
        pg8::gemm_phase<pg8::EpiScale<1>, pg8::StaticOrder, true, true>(ring, g, S, E);
    } SEAM(9);
    if (IN(10)) for (int rep = 0; rep < NREP(10); ++rep) {
        pg8::Gemm g{C.hb, C.Wdn_t, M, D, FF}; pg8::StaticOrder S; S.init(M, D, C.G, C.bx);
        pg8::EpiRes E{C.x1, C.out, nullptr, nullptr};
        pg8::gemm_phase<pg8::EpiRes, pg8::StaticOrder, true, true>(ring, g, S, E);
    } SEAM(10);
#ifdef DBG_CK
    if (lo == 10) { dbg_ck_a(C); }
    if (lo == 11) { dbg_ck_b(C); }
#elif defined(DBG_PHASE)
    if (lo == 11) { dbg_digest(C); }
#else
    if (IN(11)) { p11_final(C); }
#endif
#ifdef PROBE_A
    xcd_barrier(bar); STAMP(12);
    if (C.bx == 0) {
        __syncthreads();
        volatile LAS unsigned long long* st = (volatile LAS unsigned long long*)(C.lds + MISC_OFF + 64);
        const float ta = (float)(st[PROBE_A + 1] - st[PROBE_A]) * 0.01f, tb = (float)(st[PROBE_B + 1] - st[PROBE_B]) * 0.01f;
        for (int i = C.tid; i < (1 << 20); i += 512) C.out[i] += (i == 0) ? (ta + tb) : tb;
    }
#endif
#undef IN
#undef SEAM
}

extern "C" void kernel_launch(void* const* d_in, const int* in_sizes, int n_in, void* d_out, int out_size, void* d_ws, size_t ws_size, hipStream_t stream) {
    static int grid = 0;
    if (grid == 0) {
        if (n_in != 25 || in_sizes[0] != M * D || out_size != M * D || ws_size < 256 * MiB) { fprintf(stderr, "kernel_launch: unexpected problem shape (n_in %d, in0 %d, out %d, ws %zu); nothing launched\n", n_in, n_in > 0 ? in_sizes[0] : -1, out_size, ws_size); grid = -1; return; }
        int dev = 0, cus = 0, per_cu = 0;
        if (hipGetDevice(&dev) != hipSuccess || hipDeviceGetAttribute(&cus, hipDeviceAttributeMultiprocessorCount, dev) != hipSuccess) { grid = -1; return; }
        if (hipFuncSetAttribute((const void*)fwd_kernel, hipFuncAttributeMaxDynamicSharedMemorySize, LDS_BYTES) != hipSuccess) { fprintf(stderr, "kernel_launch: hipFuncSetAttribute failed\n"); grid = -1; return; }
        if (hipOccupancyMaxActiveBlocksPerMultiprocessor(&per_cu, (const void*)fwd_kernel, NWAVES * 64, LDS_BYTES) != hipSuccess || per_cu < 1)
            fprintf(stderr, "kernel_launch: note: occupancy query reports %d workgroups per CU\n", per_cu);
        (void)hipGetLastError();
        grid = cus;
        if (grid != 256) fprintf(stderr, "kernel_launch: note: %d CUs (built for 256)\n", grid);
    }
    if (grid < 0) return;
    if (hipMemsetAsync((char*)d_ws + WS_CTL, 0, CTL_ZERO_BYTES, stream) != hipSuccess) { fprintf(stderr, "kernel_launch: hipMemsetAsync failed\n"); return; }
    Args a{};
    for (int i = 0; i < 25; ++i) a.in[i] = (const float*)d_in[i];
    a.out = (float*)d_out; a.ws = (unsigned char*)d_ws;
    if (N_LAUNCHES == 1) {
        a.ph_lo = 0; a.ph_hi = N_PHASES;
        hipLaunchKernelGGL(fwd_kernel, dim3(grid), dim3(NWAVES * 64), LDS_BYTES, stream, a);
    } else {
        for (int li = 0; li < N_PHASES; ++li) {
#ifdef DBG_PHASE
#ifdef DBG_CK
            if (li > DBG_PHASE && li < 10) continue;
#else
            if (li > DBG_PHASE && li != 11) continue;
#endif
#endif
            a.ph_lo = li; a.ph_hi = li + 1; hipLaunchKernelGGL(fwd_kernel, dim3(grid), dim3(NWAVES * 64), LDS_BYTES, stream, a); }
    }
    const hipError_t le = hipPeekAtLastError();
    if (le != hipSuccess) fprintf(stderr, "kernel_launch: launch failed: %s\n", hipGetErrorName(le));
}
```

```cpp
#include <hip/hip_runtime.h>
#include <cstdio>
#include <cstdint>
namespace pg8 {
#define PG8_LAS __attribute__((address_space(3)))
typedef unsigned short bf16_t;
typedef short bf16x8 __attribute__((ext_vector_type(8)));
typedef float f32x4 __attribute__((ext_vector_type(4)));
typedef unsigned u32x4 __attribute__((ext_vector_type(4)));
constexpr int BM = 256, BK = 64, HALF = 128, HTB = HALF * BK * 2  , STAGE_BYTES = 8 * HTB, NXCD = 8, WGM = 8;

__host__ __device__ __forceinline__ int lds_byte(int r, int c) { const int st = (r >> 4) * 2 + (c >> 5), rr = r & 15, cc = c & 31, ob = rr * 64 + cc * 2; return st * 1024 + (ob ^ (((ob >> 9) & 1) << 5)); }
__host__ __device__ __forceinline__ void stage_rc(int b, int& R, int& C) { const int st = b / 1024, sb = b % 1024, swz = sb ^ (((sb >> 9) & 1) << 5); R = (st >> 1) * 16 + swz / 64; C = (st & 1) * 32 + (swz % 64) / 2; }
__host__ __device__ __forceinline__ int perm32(int rho) { const int n = rho >> 4, i = rho & 15; return 8 * (i >> 2) + 4 * n + (i & 3); }

struct Unit { int pm, pn; };
struct Gemm { const bf16_t* A; const bf16_t* Bt; int M, N, K; };

struct StaticOrder {
    int nM, nN, nwg, G, c;
    __host__ __device__ void init(int M, int N, int G_, int c_) { nM = M / BM; nN = N / BM; nwg = nM * nN; G = G_; c = c_; }
    __host__ __device__ __forceinline__ bool next(int i, Unit& u) const {
        const long L = (long)i * G + c; if (L >= nwg) return false;
        int wgid = (int)L; { const int q = nwg / NXCD, r = nwg % NXCD, xcd = wgid % NXCD, off = wgid / NXCD; wgid = (xcd < r ? xcd * (q + 1) : r * (q + 1) + (xcd - r) * q) + off; }
        const int nig = WGM * nN, gid = wgid / nig, fm = gid * WGM, gsz = (nM - fm) < WGM ? (nM - fm) : WGM;
        u.pm = fm + ((wgid % nig) % gsz); u.pn = (wgid % nig) / gsz; return true;
    }
    __device__ __forceinline__ void a_ready(const Unit&) const {}
    __device__ __forceinline__ void done(const Unit&) const {}
};

typedef float f32x2_t __attribute__((ext_vector_type(2))); typedef __bf16 bf16x2_t __attribute__((ext_vector_type(2)));
__device__ __forceinline__ unsigned cvt_pk_bf16(float lo, float hi) { f32x2_t v = {lo, hi}; bf16x2_t b = __builtin_convertvector(v, bf16x2_t); return __builtin_bit_cast(unsigned, b); }

__device__ __forceinline__ u32x4 pack8(const f32x4 v0, const f32x4 v1) { u32x4 w; w.x = cvt_pk_bf16(v0[0], v0[1]); w.y = cvt_pk_bf16(v0[2], v0[3]); w.z = cvt_pk_bf16(v1[0], v1[1]); w.w = cvt_pk_bf16(v1[2], v1[3]); return w; }
__device__ __forceinline__ unsigned short bf1(float f) { return (unsigned short)(cvt_pk_bf16(f, 0.f) & 0xffffu); }

struct EpiIn {
    static constexpr bool PERM = true, AFTER_DRAIN = false;
    bf16_t* P; float* small; bf16_t* halo;
    __device__ __forceinline__ void operator()(const f32x4 (&acc)[2][2][4][2], const Unit& u, int wr, int wc, int fr, int fq) const {
        const int row0 = u.pm * BM + wr * 64 + fr;
        if (u.pn < 26) {
            const int col0 = u.pn * BM + wc * 32 + 8 * fq;
#pragma unroll
            for (int ai = 0; ai < 2; ++ai)
#pragma unroll
                for (int m = 0; m < 4; ++m) { const int row = row0 + ai * HALF + m * 16; bf16_t* rowp = P + (size_t)row * 6656 + col0;
#pragma unroll
                    for (int bj = 0; bj < 2; ++bj) { const u32x4 w = pack8(acc[ai][bj][m][0], acc[ai][bj][m][1]); *(u32x4*)(rowp + bj * HALF) = w;
                        if (m == 3) { if (u.pn < 12 && fr >= 13) *(u32x4*)(halo + ((size_t)(row >> 6) * 3 + (fr - 13)) * 3072 + col0 + bj * HALF) = w; } } }
        } else if (wc == 0) {
#pragma unroll
            for (int ai = 0; ai < 2; ++ai)
#pragma unroll
                for (int m = 0; m < 4; ++m) { const int row = row0 + ai * HALF + m * 16; float* sp = small + (size_t)row * 32 + 8 * fq;
                    *(f32x4*)sp = acc[ai][0][m][0]; *(f32x4*)(sp + 4) = acc[ai][0][m][1]; }
        }
    }
};
struct EpiKV {
    static constexpr bool PERM = true, AFTER_DRAIN = false;
    bf16_t* Km; bf16_t* VT;
    __device__ __forceinline__ void operator()(const f32x4 (&acc)[2][2][4][2], const Unit& u, int wr, int wc, int fr, int fq) const {
        const int row0 = u.pm * BM + wr * 64 + fr, col0 = u.pn * BM + wc * 32 + 8 * fq;
#pragma unroll
        for (int ai = 0; ai < 2; ++ai)
#pragma unroll
            for (int m = 0; m < 4; ++m) { const int row = row0 + ai * HALF + m * 16;
#pragma unroll
                for (int bj = 0; bj < 2; ++bj) { const int c = col0 + bj * HALF;
                    if (c < 1024) { *(u32x4*)(Km + (size_t)row * 1024 + c) = pack8(acc[ai][bj][m][0], acc[ai][bj][m][1]); }
                    else { const int cc = c - 1024, b = row >> 8, mm = row & 255;
#pragma unroll
                        for (int n = 0; n < 2; ++n)
#pragma unroll
                            for (int j = 0; j < 4; ++j) VT[((size_t)b * 1024 + cc + 4 * n + j) * 256 + mm] = bf1(acc[ai][bj][m][n][j]); } } }
    }
};
struct EpiRes {
    static constexpr bool PERM = true, AFTER_DRAIN = false;
    const float* base; float* out; bf16_t* outb; float* ssp;
    __device__ __forceinline__ void operator()(const f32x4 (&acc)[2][2][4][2], const Unit& u, int wr, int wc, int fr, int fq) const {
        const int row0 = u.pm * BM + wr * 64 + fr, col0 = u.pn * BM + wc * 32 + 8 * fq;
#pragma unroll
        for (int ai = 0; ai < 2; ++ai)
#pragma unroll
            for (int m = 0; m < 4; ++m) { const int row = row0 + ai * HALF + m * 16; float ss = 0.f;
#pragma unroll
                for (int bj = 0; bj < 2; ++bj) { const size_t off = (size_t)row * 1024 + col0 + bj * HALF;
                    const f32x4 v0 = *(const f32x4*)(base + off) + acc[ai][bj][m][0], v1 = *(const f32x4*)(base + off + 4) + acc[ai][bj][m][1];
                    *(f32x4*)(out + off) = v0; *(f32x4*)(out + off + 4) = v1;
                    if (outb) *(u32x4*)(outb + off) = pack8(v0, v1);
                    ss += (v0[0] * v0[0] + v0[1] * v0[1]) + (v0[2] * v0[2] + v0[3] * v0[3]) + (v1[0] * v1[0] + v1[1] * v1[1]) + (v1[2] * v1[2] + v1[3] * v1[3]); }
                ss += __shfl_xor(ss, 16); ss += __shfl_xor(ss, 32);
                if (ssp && fq == 0) ssp[(size_t)row * 16 + u.pn * 4 + wc] = ss; }
    }
};
template <int ACT> struct EpiScale {
    static constexpr bool PERM = true, AFTER_DRAIN = false;
    bf16_t* O; int ldc; const float* ssp; float scale;
    __device__ __forceinline__ void operator()(const f32x4 (&acc)[2][2][4][2], const Unit& u, int wr, int wc, int fr, int fq) const {
        const int row0 = u.pm * BM + wr * 64 + fr, col0 = u.pn * BM + wc * 32 + 8 * fq;
#pragma unroll
        for (int ai = 0; ai < 2; ++ai)
#pragma unroll
            for (int m = 0; m < 4; ++m) { const int row = row0 + ai * HALF + m * 16;
                const f32x4* sp = (const f32x4*)(ssp + (size_t)row * 16); const f32x4 s0 = sp[0], s1 = sp[1], s2 = sp[2], s3 = sp[3];
                const float tot = ((s0[0] + s0[1]) + (s0[2] + s0[3])) + ((s1[0] + s1[1]) + (s1[2] + s1[3])) + ((s2[0] + s2[1]) + (s2[2] + s2[3])) + ((s3[0] + s3[1]) + (s3[2] + s3[3]));
                const float rs = rsqrtf(tot * (1.0f / 1024.0f) + 1e-6f) * scale;
#pragma unroll
                for (int bj = 0; bj < 2; ++bj) { f32x4 v0 = acc[ai][bj][m][0] * rs, v1 = acc[ai][bj][m][1] * rs;
                    if (ACT == 1) {
#pragma unroll
                        for (int j = 0; j < 4; ++j) { const float a = fmaxf(v0[j], 0.f), b = fmaxf(v1[j], 0.f); v0[j] = a * a; v1[j] = b * b; } }
                    *(u32x4*)(O + (size_t)row * ldc + col0 + bj * HALF) = pack8(v0, v1); } }
    }
};

template <class Epi, class Sched, bool ALIGN_EPI = false, bool SP2 = false>
__device__ __forceinline__ void gemm_phase(PG8_LAS unsigned char* lds, const Gemm g, const Sched& S, const Epi& E) {
    const int tid = threadIdx.x, wid = __builtin_amdgcn_readfirstlane(tid >> 6), lane = tid & 63, wr = wid >> 2, wc = wid & 3, fr = lane & 15, fq = lane >> 4;
    const int K = g.K, nt = K / BK;
    unsigned voffA[2], voffB[2];
#pragma unroll
    for (int i = 0; i < 2; ++i) { int R, C; stage_rc(tid * 16 + i * 8192, R, C); const int Rb = Epi::PERM ? ((R & ~31) + perm32(R & 31)) : R;
        voffA[i] = (unsigned)(R * K + C) * 2u; voffB[i] = (unsigned)(Rb * K + C) * 2u; }
    const size_t kstep = (size_t)(BK * 2);
    const size_t hstep = (size_t)HALF * K * 2;
    const size_t tstep = 2 * hstep;
    const unsigned ldsw = (unsigned)wid * 1024u;
    const int aoff = lds_byte(wr * 64 + fr, fq * 8), boff = lds_byte(wc * 32 + fr, fq * 8);
#define PG8_SA(b, h) (((b) * 2 + (h)) * HTB)
#define PG8_SB(b, h) ((4 + (b) * 2 + (h)) * HTB)
#define PG8_STAGE(bufoff, gbase, voff) do { _Pragma("unroll") for (int _i = 0; _i < 2; ++_i) \
        __builtin_amdgcn_global_load_lds((const unsigned*)((const char*)(gbase) + (voff)[_i]), (PG8_LAS unsigned*)(lds + (bufoff) + ldsw + _i * 8192), 16, 0, 0); } while (0)
#define PG8_LDA(dst, b, h) do { _Pragma("unroll") for (int m = 0; m < 4; ++m) _Pragma("unroll") for (int k = 0; k < 2; ++k) dst[m][k] = *(const PG8_LAS bf16x8*)(lds + PG8_SA(b, h) + aoff + m * 2048 + k * 1024); } while (0)
#define PG8_LDB(dst, b, h) do { _Pragma("unroll") for (int n = 0; n < 2; ++n) _Pragma("unroll") for (int k = 0; k < 2; ++k) dst[n][k] = *(const PG8_LAS bf16x8*)(lds + PG8_SB(b, h) + boff + n * 2048 + k * 1024); } while (0)
#define PG8_MMA(ai, bj, At, Bt) do { __builtin_amdgcn_s_setprio(1); _Pragma("unroll") for (int m = 0; m < 4; ++m) _Pragma("unroll") for (int n = 0; n < 2; ++n) _Pragma("unroll") for (int k = 0; k < 2; ++k) \
        acc[ai][bj][m][n] = __builtin_amdgcn_mfma_f32_16x16x32_bf16(Bt[n][k], At[m][k], acc[ai][bj][m][n], 0, 0, 0); __builtin_amdgcn_s_setprio(0); } while (0)
#define PG8_WAIT_V(n) asm volatile("s_waitcnt vmcnt(" #n ")" ::: "memory")
#define PG8_WAIT_L(n) asm volatile("s_waitcnt lgkmcnt(" #n ")" ::: "memory")
#define PG8_BAR __builtin_amdgcn_s_barrier()
#define PG8_SCHED __builtin_amdgcn_sched_barrier(0)
    Unit cur, nxt; int ui = 0;
    if (!S.next(0, cur)) return;
    f32x4 acc[2][2][4][2];
#pragma unroll
    for (int a = 0; a < 2; ++a)
#pragma unroll
        for (int b = 0; b < 2; ++b)
#pragma unroll
            for (int m = 0; m < 4; ++m)
#pragma unroll
                for (int n = 0; n < 2; ++n) acc[a][b][m][n] = (f32x4){0.f, 0.f, 0.f, 0.f};
    bf16x8 At[4][2], B0[2][2], B1[2][2];
    const char* cA = (const char*)g.A + (size_t)cur.pm * tstep; const char* cB = (const char*)g.Bt + (size_t)cur.pn * tstep;
    S.a_ready(cur);
    if constexpr (SP2) {
        PG8_STAGE(PG8_SB(0, 0), cB, voffB); PG8_STAGE(PG8_SB(0, 1), cB + hstep, voffB); PG8_STAGE(PG8_SA(0, 0), cA, voffA); PG8_STAGE(PG8_SA(0, 1), cA + hstep, voffA);
        if (wr == 1) PG8_BAR;
        PG8_WAIT_V(2); PG8_BAR;
        PG8_STAGE(PG8_SB(1, 0), cB + kstep, voffB); PG8_STAGE(PG8_SA(1, 0), cA + kstep, voffA); PG8_STAGE(PG8_SB(1, 1), cB + hstep + kstep, voffB);
        PG8_WAIT_V(6); PG8_BAR;
    } else {
        PG8_STAGE(PG8_SB(0, 0), cB, voffB); PG8_STAGE(PG8_SA(0, 0), cA, voffA); PG8_STAGE(PG8_SB(0, 1), cB + hstep, voffB); PG8_STAGE(PG8_SA(0, 1), cA + hstep, voffA);
        if (wr == 1) PG8_BAR;
        PG8_WAIT_V(4); PG8_BAR;
        PG8_STAGE(PG8_SB(1, 0), cB + kstep, voffB); PG8_STAGE(PG8_SA(1, 0), cA + kstep, voffA); PG8_STAGE(PG8_SB(1, 1), cB + hstep + kstep, voffB);
        PG8_WAIT_V(6); PG8_BAR;
    }
    for (;;) {
        const bool has_next = S.next(ui + 1, nxt);
        const char* nA = has_next ? (const char*)g.A + (size_t)nxt.pm * tstep : cA; const char* nB = has_next ? (const char*)g.Bt + (size_t)nxt.pn * tstep : cB;
        for (int t = 0; t < nt; t += 2) {
            const bool last = (t == nt - 2);
            const char* a1 = cA + (size_t)(t + 1) * kstep;
            const char* a2 = last ? nA : cA + (size_t)(t + 2) * kstep; const char* b2 = last ? nB : cB + (size_t)(t + 2) * kstep;
            const char* a3 = a2 + kstep; const char* b3 = b2 + kstep;
            if (last && has_next) S.a_ready(nxt);
            if constexpr (SP2) {
            PG8_LDB(B0, 0, 0); PG8_LDB(B1, 0, 1); PG8_SCHED; PG8_LDA(At, 0, 0); PG8_STAGE(PG8_SA(1, 1), a1 + hstep, voffA);
            PG8_WAIT_V(8); PG8_WAIT_L(0); PG8_BAR; PG8_MMA(0, 0, At, B0); PG8_MMA(0, 1, At, B1); PG8_BAR; PG8_SCHED;
            PG8_LDA(At, 0, 1); PG8_STAGE(PG8_SB(0, 0), b2, voffB); PG8_STAGE(PG8_SB(0, 1), b2 + hstep, voffB); PG8_STAGE(PG8_SA(0, 0), a2, voffA);
            PG8_WAIT_V(8); PG8_WAIT_L(0); PG8_BAR; PG8_MMA(1, 0, At, B0); PG8_MMA(1, 1, At, B1); PG8_BAR; PG8_SCHED;
            PG8_LDB(B0, 1, 0); PG8_LDB(B1, 1, 1); PG8_SCHED; PG8_LDA(At, 1, 0); PG8_STAGE(PG8_SA(0, 1), a2 + hstep, voffA);
            PG8_WAIT_V(8); PG8_WAIT_L(0); PG8_BAR; PG8_MMA(0, 0, At, B0); PG8_MMA(0, 1, At, B1); PG8_BAR; PG8_SCHED;
            PG8_LDA(At, 1, 1); PG8_STAGE(PG8_SB(1, 0), b3, voffB); PG8_STAGE(PG8_SB(1, 1), b3 + hstep, voffB); PG8_STAGE(PG8_SA(1, 0), a3, voffA);
            PG8_WAIT_V(8); PG8_WAIT_L(0); PG8_BAR; PG8_MMA(1, 0, At, B0); PG8_MMA(1, 1, At, B1); PG8_BAR; PG8_SCHED;
            } else {
            PG8_LDB(B0, 0, 0); PG8_SCHED; PG8_LDA(At, 0, 0); PG8_STAGE(PG8_SA(1, 1), a1 + hstep, voffA);
            PG8_WAIT_L(8); PG8_BAR; PG8_WAIT_L(0); PG8_MMA(0, 0, At, B0); PG8_BAR; PG8_SCHED;
            PG8_LDB(B1, 0, 1); PG8_STAGE(PG8_SB(0, 0), b2, voffB);
            PG8_BAR; PG8_WAIT_L(0); PG8_MMA(0, 1, At, B1); PG8_BAR;
            PG8_LDA(At, 0, 1); PG8_STAGE(PG8_SA(0, 0), a2, voffA);
            PG8_BAR; PG8_WAIT_L(0); PG8_MMA(1, 0, At, B0); PG8_BAR; PG8_SCHED;
            PG8_STAGE(PG8_SB(0, 1), b2 + hstep, voffB);
            PG8_WAIT_V(6); PG8_BAR; PG8_MMA(1, 1, At, B1); PG8_BAR;
            PG8_LDB(B0, 1, 0); PG8_SCHED; PG8_LDA(At, 1, 0); PG8_STAGE(PG8_SA(0, 1), a2 + hstep, voffA);
            PG8_WAIT_L(8); PG8_BAR; PG8_WAIT_L(0); PG8_MMA(0, 0, At, B0); PG8_BAR; PG8_SCHED;
            PG8_LDB(B1, 1, 1); PG8_STAGE(PG8_SB(1, 0), b3, voffB);
            PG8_BAR; PG8_WAIT_L(0); PG8_MMA(0, 1, At, B1); PG8_BAR;
            PG8_LDA(At, 1, 1); PG8_STAGE(PG8_SA(1, 0), a3, voffA);
            PG8_BAR; PG8_WAIT_L(0); PG8_MMA(1, 0, At, B0); PG8_BAR; PG8_SCHED;
            PG8_STAGE(PG8_SB(1, 1), b3 + hstep, voffB);
            PG8_WAIT_V(6); PG8_BAR; PG8_MMA(1, 1, At, B1); PG8_BAR;
            }
        }
        if constexpr (ALIGN_EPI) { if (wr == 0) PG8_BAR; }
        if constexpr (!Epi::AFTER_DRAIN) { E(acc, cur, wr, wc, fr, fq); S.done(cur); }
        if (!has_next) break;
#pragma unroll
        for (int a = 0; a < 2; ++a)
#pragma unroll
            for (int b = 0; b < 2; ++b)
#pragma unroll
                for (int m = 0; m < 4; ++m)
#pragma unroll
                    for (int n = 0; n < 2; ++n) acc[a][b][m][n] = (f32x4){0.f, 0.f, 0.f, 0.f};
        cur = nxt; cA = nA; cB = nB; ++ui;
        if constexpr (ALIGN_EPI) { if (wr == 1) PG8_BAR; }
    }
    PG8_WAIT_V(0);
    if constexpr (!ALIGN_EPI) { if (wr == 0) PG8_BAR; }
    PG8_BAR;
    if constexpr (Epi::AFTER_DRAIN) { E.fused(acc, cur, wr, wc, fr, fq, lds, wid, lane); S.done(cur); }
#undef PG8_SA
#undef PG8_SB
#undef PG8_STAGE
#undef PG8_LDA
#undef PG8_LDB
#undef PG8_MMA
#undef PG8_WAIT_V
#undef PG8_WAIT_L
#undef PG8_BAR
#undef PG8_SCHED
}
}

constexpr int NWAVES = 8;
constexpr int BATCH = 2, T = 8192, D = 1024, M = BATCH * T, FF = 4096, MIXD = 2048, MEMLEN = 256;
constexpr int NP = 6656;
constexpr int NIN = 6912;
constexpr int PQ = 0, PK = 1024, PV = 2048, PZG = 3072, PZS = 4096, PXS = 5120, PB = 6144, PC = 6400;
constexpr float EPS = 1e-6f;
constexpr size_t MiB = 1u << 20;
constexpr size_t WS_CTL = 0, CTL_ZERO_BYTES = 64 * 1024;
constexpr size_t WS_CDV = 512 * 1024;
constexpr size_t WS_P = 1 * MiB;
constexpr size_t WS_WIN = 209 * MiB;
constexpr size_t WS_WKV = WS_WIN + 13 * MiB + 512 * 1024;
constexpr size_t WS_WOUT = WS_WKV + 4 * MiB;
constexpr size_t WS_WQ = WS_WOUT + 4 * MiB, WS_WO = WS_WQ + 2 * MiB, WS_WUP = WS_WO + 2 * MiB, WS_WDN = WS_WUP + 8 * MiB;
constexpr size_t WS_KMEM = WS_WDN + 8 * MiB;
constexpr size_t WS_VT = WS_KMEM + 1 * MiB;
constexpr size_t WS_MN = WS_VT + 1 * MiB;
constexpr size_t WS_SMALL = WS_MN + 1 * MiB;
constexpr size_t WS_END = WS_SMALL + 2 * MiB;
static_assert(WS_END <= 256 * MiB, "d_ws map");
constexpr size_t WS_CC = WS_WIN, WS_CB = WS_WIN + 8 * MiB;
static_assert(WS_CB + 8 * MiB <= WS_WOUT, "CB overlays w_in tail + wkv only");
constexpr size_t WS_X1 = 1 * MiB, WS_X1B = 65 * MiB, WS_Q = 97 * MiB, WS_AO = 129 * MiB, WS_HB = 97 * MiB;
static_assert(WS_HB + 128 * MiB <= WS_WOUT, "hb overlay");
constexpr size_t DO_XN1 = 0, DO_KDT = 0, DO_ATTN = 32 * MiB, DO_HALO = 48 * MiB, DO_BT = 52 * MiB + 512 * 1024;
constexpr int CW_BAR = 4096;
constexpr int RING_BYTES = 131072;
constexpr int LDS_BYTES = 147456;
constexpr int MISC_OFF = LDS_BYTES - 512;

#define GAS __attribute__((address_space(1)))
#define LAS __attribute__((address_space(3)))
typedef unsigned short bf16;
typedef unsigned u32x4 __attribute__((ext_vector_type(4)));
typedef unsigned u32x2 __attribute__((ext_vector_type(2)));
typedef float f32x4 __attribute__((ext_vector_type(4)));
typedef short bf16x8 __attribute__((ext_vector_type(8)));
typedef GAS unsigned gu32;
#define RLX_AGENT __ATOMIC_RELAXED, __HIP_MEMORY_SCOPE_AGENT
#define LDS_WAIT() asm volatile("s_waitcnt lgkmcnt(0)" ::: "memory")
#define VM_WAIT() asm volatile("s_waitcnt vmcnt(0)" ::: "memory")
__device__ __forceinline__ unsigned pk2(float lo, float hi) { return pg8::cvt_pk_bf16(lo, hi); }
__device__ __forceinline__ bf16 f2bf(float f) { return (bf16)(pk2(f, 0.f) & 0xffffu); }
__device__ __forceinline__ float bf2f(bf16 b) { return __uint_as_float((unsigned)b << 16); }
__device__ __forceinline__ float bflo(unsigned w) { return __uint_as_float(w << 16); }
__device__ __forceinline__ float bfhi(unsigned w) { return __uint_as_float(w & 0xffff0000u); }
__device__ __forceinline__ void unpack8(const u32x4 w, float* f) { f[0] = bflo(w.x); f[1] = bfhi(w.x); f[2] = bflo(w.y); f[3] = bfhi(w.y); f[4] = bflo(w.z); f[5] = bfhi(w.z); f[6] = bflo(w.w); f[7] = bfhi(w.w); }
__device__ __forceinline__ u32x4 pack8f(const float* f) { u32x4 w; w.x = pk2(f[0], f[1]); w.y = pk2(f[2], f[3]); w.z = pk2(f[4], f[5]); w.w = pk2(f[6], f[7]); return w; }
__device__ __forceinline__ u32x2 pack4(const f32x4 v) { u32x2 w; w.x = pk2(v[0], v[1]); w.y = pk2(v[2], v[3]); return w; }
__device__ __forceinline__ float silu_f(float y) { return y * __builtin_amdgcn_rcpf(1.f + __expf(-y)); }
__device__ __forceinline__ float sigmoid_f(float y) { return __builtin_amdgcn_rcpf(1.f + __expf(-y)); }
__device__ __forceinline__ float softplus_f(float x) { return fmaxf(x, 0.f) + log1pf(__expf(-fabsf(x))); }
__device__ __forceinline__ f32x4 mfma16(bf16x8 a, bf16x8 b, f32x4 c) { return __builtin_amdgcn_mfma_f32_16x16x32_bf16(a, b, c, 0, 0, 0); }
__device__ __forceinline__ float wave_sum(float v) {
#pragma unroll
    for (int o = 1; o < 64; o <<= 1) v += __shfl_xor(v, o);
    return v;
}
__device__ __forceinline__ int opaque(int x) { asm volatile("" : "+v"(x)); return x; }
#define XB_TMO      128
#define XB_XCNT(j)  (256  + 64 * (j))
#define XB_XSUB(j)  (1280 + 64 * (j))
#define XB_XGEN(j)  (2304 + 64 * (j))
#define XB_TOP      3328
#define XB_TOPGEN   3392
#define XCD_BAR_WORDS 3456
#define XB_SPIN_CAP (1u << 18)

__device__ __forceinline__ unsigned xb_ld(unsigned* p)              { return __hip_atomic_load(p, __ATOMIC_RELAXED, __HIP_MEMORY_SCOPE_AGENT); }
__device__ __forceinline__ unsigned xb_add(unsigned* p, unsigned v) { return __hip_atomic_fetch_add(p, v, __ATOMIC_RELAXED, __HIP_MEMORY_SCOPE_AGENT); }
__device__ __forceinline__ unsigned xb_xcc_id() { return (unsigned)__builtin_amdgcn_s_getreg((3 << 11) | 20) & 0xFu; }
#define XB_SPIN(cond, bar) do { unsigned _sp = 0; while (cond) { __builtin_amdgcn_s_sleep(1); \
    if ((++_sp & 255u) == 0u) { if (xb_ld(&(bar)[XB_TMO])) break; if (_sp > XB_SPIN_CAP) { atomicAdd(&(bar)[XB_TMO], 1u); break; } } } } while (0)

struct XcdBarrier {
    unsigned* bar; unsigned x;
    volatile LAS unsigned* st;
};

__device__ __forceinline__ XcdBarrier xcd_barrier_post(unsigned* bar, volatile LAS unsigned* st) {
    XcdBarrier b; b.bar = bar; b.x = xb_xcc_id(); b.st = st;
    if (threadIdx.x == 0) (void)xb_add(&bar[XB_XCNT(b.x)], 1u);
    return b;
}
__device__ __forceinline__ void xcd_barrier_complete(unsigned* bar, unsigned x, unsigned& nloc, unsigned& nx) {
    const unsigned G = gridDim.x * gridDim.y * gridDim.z;
    unsigned sum, cnt, mine, sp = 0u;
    for (;;) {
        sum = 0u; cnt = 0u; mine = 0u;
#pragma unroll
        for (unsigned j = 0; j < 16; ++j) { const unsigned c = xb_ld(&bar[XB_XCNT(j)]); sum += c; cnt += (c > 0u) ? 1u : 0u; mine = (j == x) ? c : mine; }
        if (sum == G) break;
        __builtin_amdgcn_s_sleep(1);
        if ((++sp & 255u) == 0u) { if (xb_ld(&bar[XB_TMO])) break; if (sp > XB_SPIN_CAP) { atomicAdd(&bar[XB_TMO], 1u); break; } }
    }
    nloc = mine > 0u ? mine : 1u; nx = cnt > 0u ? cnt : 1u;
}

__device__ __forceinline__ void xcd_barrier(const XcdBarrier& b) {
    asm volatile("s_waitcnt vmcnt(0)" ::: "memory");
    __syncthreads();
    if (threadIdx.x == 0) {
        unsigned* bar = b.bar;
        __builtin_amdgcn_s_waitcnt(0);
        unsigned nloc = b.st[0], nx = b.st[1];
        if (nloc == 0u) { xcd_barrier_complete(bar, b.x, nloc, nx); b.st[0] = nloc; b.st[1] = nx; }
        const unsigned old = xb_add(&bar[XB_XSUB(b.x)], 1u);
        const unsigned gen = old / nloc;
        if (old + 1u == (gen + 1u) * nloc) {
            __builtin_amdgcn_fence(__ATOMIC_RELEASE, "agent");
            asm volatile("s_waitcnt vmcnt(0)" ::: "memory");
            const unsigned og = xb_add(&bar[XB_TOP], 1u);
            const unsigned tg = og / nx;
            if (og + 1u == (tg + 1u) * nx) xb_add(&bar[XB_TOPGEN], 1u);
            else XB_SPIN(xb_ld(&bar[XB_TOPGEN]) == tg, bar);
            __builtin_amdgcn_fence(__ATOMIC_ACQUIRE, "agent");
            xb_add(&bar[XB_XGEN(b.x)], 1u);
            asm volatile("s_waitcnt vmcnt(0)" ::: "memory");
        } else {
            XB_SPIN(xb_ld(&bar[XB_XGEN(b.x)]) == gen, bar);
            __builtin_amdgcn_fence(__ATOMIC_ACQUIRE, "agent");
            asm volatile("s_waitcnt vmcnt(0)" ::: "memory");
        }
    }
    __syncthreads();
}

struct Ctx {
    LAS unsigned char* lds;
    int tid, lane, wave, vcu, G, bx;
    const float *x, *mem, *norm1_w, *w_in, *gdn_conv_w, *gdn_a_log, *gdn_dt_bias, *gdn_norm_w, *ssm_conv_w, *ssm_conv_b, *ssm_a_log, *ssm_dt_bias, *ssm_d, *ssm_norm_w,
                *w_out, *norm2_w, *mem_norm_w, *wq, *wk, *wv, *wo, *norm3_w, *w_up, *w_down, *final_norm_w;
    float* out;
    unsigned char* ws; unsigned char* dob;
    bf16 *P, *Win_t, *Wkv_t, *Wout_t, *Wq_t, *Wo_t, *Wup_t, *Wdn_t, *Kmem, *VT, *MN, *XN1, *halo, *kdT, *attn, *BT, *Cc, *CB, *mix, *x1b, *qb, *ao, *hb;
    float *small, *cdv, *ssm_ss, *ssp, *x1;
};

template <class SrcCol>
__device__ __forceinline__ void p0_item(const float* W, int K, int Nsrc, bf16* WT, int nblk, LAS float* scr, int item, int lane, const float* kscale, SrcCol srccol) {
    const int kb = item / nblk, nb = item % nblk, k0 = 64 * kb, n0 = 32 * nb;
    const int sc = srccol(n0 + (lane & 31));
#pragma unroll 8
    for (int i = 0; i < 32; ++i) { const int kk = 2 * i + (lane >> 5); float v = sc >= 0 ? W[(size_t)(k0 + kk) * Nsrc + sc] : 0.f; if (kscale) v *= kscale[k0 + kk]; scr[kk * 33 + (lane & 31)] = v; }
    LDS_WAIT(); asm volatile("" ::: "memory");
    const int c = lane & 7;
#pragma unroll
    for (int j = 0; j < 4; ++j) { const int n = (lane >> 3) + 8 * j; const LAS float* s = scr + (8 * c) * 33 + n;
        u32x4 o; o.x = pk2(s[0 * 33], s[1 * 33]); o.y = pk2(s[2 * 33], s[3 * 33]); o.z = pk2(s[4 * 33], s[5 * 33]); o.w = pk2(s[6 * 33], s[7 * 33]);
        *(u32x4*)(WT + (size_t)(n0 + n) * K + k0 + 8 * c) = o; }
    LDS_WAIT(); asm volatile("" ::: "memory");
}
__device__ __forceinline__ void rms_row_to_bf16(const float* xrow, const float* w, bf16* orow, int lane) {
    const f32x4* xr = (const f32x4*)xrow + lane; const f32x4* wr = (const f32x4*)w + lane;
    f32x4 v[4]; float s = 0.f;
#pragma unroll
    for (int j = 0; j < 4; ++j) { v[j] = xr[64 * j]; s += (v[j][0] * v[j][0] + v[j][1] * v[j][1]) + (v[j][2] * v[j][2] + v[j][3] * v[j][3]); }
    const float rstd = rsqrtf(wave_sum(s) * (1.f / 1024.f) + EPS);
    u32x2* o8 = (u32x2*)orow + lane;
#pragma unroll
    for (int j = 0; j < 4; ++j) { const f32x4 o = v[j] * rstd * wr[64 * j]; o8[64 * j] = pack4(o); }
}
__device__ __forceinline__ void p0_prologue(const Ctx& C, int part, int gw, int NGW) {
    LAS float* scr = (LAS float*)(C.lds + C.wave * 16384);
    const int lane = C.lane;
    constexpr int I_IN = 16 * 216, I_KV = 16 * 32, I_OUT = 32 * 32, I_Q = 16 * 32, I_UP = 16 * 128, I_DN = 64 * 32;
    if (part == 0) {
        constexpr int NITEMS = I_IN + 2 * I_KV;
        for (int it = gw; it < NITEMS; it += NGW) {
            int r = it;
            if (r < I_IN) { p0_item(C.w_in, 1024, 6688, C.Win_t, 216, scr, r, lane, nullptr,
                                    [](int n) { return n < 4096 ? n : (n < 6656 ? n + 16 : (n < 6672 ? n - 2560 : (n < 6688 ? n : -1))); }); continue; } r -= I_IN;
            if (r < I_KV) { p0_item(C.wk, 1024, 1024, C.Wkv_t, 32, scr, r, lane, nullptr, [](int n) { return n; }); continue; } r -= I_KV;
            p0_item(C.wv, 1024, 1024, C.Wkv_t + (size_t)1024 * 1024, 32, scr, r, lane, nullptr, [](int n) { return n; });
        }
        for (int m = gw; m < M; m += NGW) rms_row_to_bf16(C.x + (size_t)m * D, C.norm1_w, C.XN1 + (size_t)m * D, lane);
        for (int m = gw; m < BATCH * MEMLEN; m += NGW) rms_row_to_bf16(C.mem + (size_t)m * D, C.mem_norm_w, C.MN + (size_t)m * D, lane);
    } else {
        constexpr int NITEMS = I_OUT + 2 * I_Q + I_UP + I_DN;
        for (int it = gw; it < NITEMS; it += NGW) {
            int r = it;
            if (r < I_OUT) { p0_item(C.w_out, 2048, 1024, C.Wout_t, 32, scr, r, lane, nullptr, [](int n) { return n; }); continue; } r -= I_OUT;
            if (r < I_Q) { p0_item(C.wq, 1024, 1024, C.Wq_t, 32, scr, r, lane, C.norm2_w, [](int n) { return n; }); continue; } r -= I_Q;
            if (r < I_Q) { p0_item(C.wo, 1024, 1024, C.Wo_t, 32, scr, r, lane, nullptr, [](int n) { return n; }); continue; } r -= I_Q;
            if (r < I_UP) { p0_item(C.w_up, 1024, 4096, C.Wup_t, 128, scr, r, lane, C.norm3_w, [](int n) { return n; }); continue; } r -= I_UP;
            p0_item(C.w_down, 4096, 1024, C.Wdn_t, 32, scr, r, lane, nullptr, [](int n) { return n; });
        }
    }
}

__device__ __forceinline__ void gdn_raw16(const Ctx& C, int t0, int gc, int c, int i, int col, u32x4* raw) {
#pragma unroll
    for (int kk = 0; kk < 4; ++kk) {
        const int ri = i - 3 + kk;
        u32x4 a = (u32x4){0u, 0u, 0u, 0u}, b = a;
        if (ri >= 0) { const u32x4* s = (const u32x4*)(C.P + (size_t)(t0 + ri) * NP + col); a = s[0]; b = s[1]; }
        else if (c != 0) { const u32x4* s = (const u32x4*)(C.halo + ((size_t)(gc - 1) * 3 + (3 + ri)) * 3072 + col); a = s[0]; b = s[1]; }
        raw[2 * kk] = a; raw[2 * kk + 1] = b;
    }
}
__device__ __forceinline__ void gdn_conv16(const Ctx& C, int col, const u32x4* raw, float* outv) {
    float acc[16];
#pragma unroll
    for (int x = 0; x < 16; ++x) acc[x] = 0.f;
#pragma unroll
    for (int kk = 0; kk < 4; ++kk) {
        float xv[16]; unpack8(raw[2 * kk], xv); unpack8(raw[2 * kk + 1], xv + 8);
        const f32x4* wp = (const f32x4*)(C.gdn_conv_w + (size_t)kk * 3072 + col);
#pragma unroll
        for (int j = 0; j < 4; ++j) { const f32x4 w = wp[j];
#pragma unroll
            for (int e = 0; e < 4; ++e) acc[4 * j + e] += w[e] * xv[4 * j + e]; }
    }
#pragma unroll
    for (int x = 0; x < 16; ++x) outv[x] = silu_f(acc[x]);
}
__device__ __forceinline__ void gdn_prep_unit(const Ctx& C, int un, bool st = true) {
    const int wv = C.wave;
#define GP_IDX() const int tid = opaque(C.tid), lane = tid & 63, r = lane & 15, q = lane >> 4; (void)r; (void)q; (void)lane;
    const int b = un >> 10, h = (un >> 7) & 7, c = un & 127;
    const int t0 = b * T + c * 64, gc = b * 128 + c;
    LAS bf16* QN = (LAS bf16*)(C.lds + 0);
    LAS bf16* KN = (LAS bf16*)(C.lds + 17408);
    LAS bf16* KB = (LAS bf16*)(C.lds + 34816);
    LAS bf16* VBT = (LAS bf16*)(C.lds + 52224);
    LAS bf16* KBGT = (LAS bf16*)(C.lds + 70656);
    LAS float* LM = (LAS float*)(C.lds + 89088);
    LAS bf16* TB = (LAS bf16*)(C.lds + 105728);
    LAS float* GCS = (LAS float*)(C.lds + 114944);
    LAS bf16* KDT = (LAS bf16*)(C.lds + 115200);
    float qv[16], kv[16];
    {
        GP_IDX(); const int i = tid >> 3, d0 = (tid & 7) * 16;
        const float beta = sigmoid_f(C.small[(size_t)(t0 + i) * 32 + h]);
        u32x4 rawq[8], rawk[8], rawv[8];
        gdn_raw16(C, t0, gc, c, i, PQ + h * 128 + d0, rawq); gdn_raw16(C, t0, gc, c, i, PK + h * 128 + d0, rawk); gdn_raw16(C, t0, gc, c, i, PV + h * 128 + d0, rawv);
        asm volatile("" ::: "memory");
        {
            gdn_conv16(C, PQ + h * 128 + d0, rawq, qv); asm volatile("" ::: "memory");
            float sq = 0.f;
#pragma unroll
            for (int x = 0; x < 16; ++x) sq += qv[x] * qv[x];
            sq += __shfl_xor(sq, 1); sq += __shfl_xor(sq, 2); sq += __shfl_xor(sq, 4);
            const float rq = rsqrtf(sq + EPS) * 0.08838834764831845f;
#pragma unroll
            for (int x = 0; x < 16; ++x) qv[x] *= rq;
            *(LAS u32x4*)(QN + i * 136 + d0) = pack8f(qv); *(LAS u32x4*)(QN + i * 136 + d0 + 8) = pack8f(qv + 8);
        }
        {
            gdn_conv16(C, PK + h * 128 + d0, rawk, kv); asm volatile("" ::: "memory");
            float sk = 0.f;
#pragma unroll
            for (int x = 0; x < 16; ++x) sk += kv[x] * kv[x];
            sk += __shfl_xor(sk, 1); sk += __shfl_xor(sk, 2); sk += __shfl_xor(sk, 4);
            const float rk = rsqrtf(sk + EPS);
            float t1[16];
#pragma unroll
            for (int x = 0; x < 16; ++x) { kv[x] *= rk; t1[x] = kv[x] * beta; }
            *(LAS u32x4*)(KN + i * 136 + d0) = pack8f(kv); *(LAS u32x4*)(KN + i * 136 + d0 + 8) = pack8f(kv + 8);
            *(LAS u32x4*)(KB + i * 136 + d0) = pack8f(t1); *(LAS u32x4*)(KB + i * 136 + d0 + 8) = pack8f(t1 + 8);
        }
        {
            float vv[16];
            gdn_conv16(C, PV + h * 128 + d0, rawv, vv); asm volatile("" ::: "memory");
            LAS bf16* vb = VBT + d0 * 72 + i;
#pragma unroll
            for (int x = 0; x < 16; ++x) vb[x * 72] = f2bf(vv[x] * beta);
        }
        if (tid < 64) {
            float g = -expf(C.gdn_a_log[h]) * softplus_f(C.small[(size_t)(t0 + tid) * 32 + 8 + h] + C.gdn_dt_bias[h]);
#pragma unroll
            for (int o = 1; o < 64; o <<= 1) { const float v2 = __shfl_up(g, o); if (lane >= o) g += v2; }
            GCS[tid] = g;
        }
    }
    __syncthreads();
    {
        GP_IDX(); const int i = tid >> 3, d0 = (tid & 7) * 16;
        const float gi = GCS[i], gl = GCS[63];
        const float eg = expf(gi), ek = expf(gl - gi);
        const float beta = sigmoid_f(C.small[(size_t)(t0 + i) * 32 + h]);
        {
            float t2[16];
#pragma unroll
            for (int x = 0; x < 16; ++x) t2[x] = qv[x] * eg;
            u32x4* qd = (u32x4*)(C.P + (size_t)(t0 + i) * NP + PQ + h * 128 + d0); if (st) { qd[0] = pack8f(t2); qd[1] = pack8f(t2 + 8); }
        }
        LAS bf16* kg = KBGT + d0 * 72 + i; LAS bf16* kd = KDT + d0 * 72 + i; const float bg = beta * eg;
#pragma unroll
        for (int x = 0; x < 16; ++x) { kg[x * 72] = f2bf(kv[x] * bg); kd[x * 72] = f2bf(kv[x] * ek); }
        if (tid == 0 && st) C.cdv[un] = expf(gl);
    }
    __syncthreads();
    {
        GP_IDX();
        const int mt = wv & 3, which = wv >> 2;
        const LAS bf16* X = which ? QN : KB;
        bf16x8 xa[4];
#pragma unroll
        for (int ks = 0; ks < 4; ++ks) xa[ks] = *(const LAS bf16x8*)(X + (16 * mt + r) * 136 + 32 * ks + 8 * q);
#pragma unroll
        for (int nt = 0; nt < 4; ++nt) {
            bf16x8 kf[4];
#pragma unroll
            for (int ks = 0; ks < 4; ++ks) kf[ks] = *(const LAS bf16x8*)(KN + (16 * nt + r) * 136 + 32 * ks + 8 * q);
            f32x4 acc = (f32x4){0.f, 0.f, 0.f, 0.f};
            if (which == 0) {
#pragma unroll
                for (int ks = 0; ks < 4; ++ks) acc = mfma16(xa[ks], kf[ks], acc);
                const int jj = 16 * nt + r; const float gj = GCS[jj];
#pragma unroll
                for (int t = 0; t < 4; ++t) { const int ii = 16 * mt + 4 * q + t; LM[ii * 65 + jj] = (ii > jj) ? acc[t] * expf(GCS[ii] - gj) : 0.f; }
            } else {
#pragma unroll
                for (int ks = 0; ks < 4; ++ks) acc = mfma16(kf[ks], xa[ks], acc);
                const int ii = 16 * mt + r; const float gi = GCS[ii]; f32x4 o;
#pragma unroll
                for (int t = 0; t < 4; ++t) { const int jj = 16 * nt + 4 * q + t; o[t] = (ii >= jj) ? acc[t] * expf(gi - GCS[jj]) : 0.f; }
                if (st) *(u32x2*)(C.attn + ((size_t)un * 64 + ii) * 64 + 16 * nt + 4 * q) = pack4(o);
            }
        }
        for (int ch = tid; ch < 1024; ch += 512) { const int d = ch >> 3, part = ch & 7;
            const u32x4 kv_ = *(const LAS u32x4*)(KDT + d * 72 + part * 8); if (st) *(u32x4*)(C.kdT + ((size_t)un * 128 + d) * 64 + part * 8) = kv_; }
    }
    __syncthreads();
    LAS float* TM = (LAS float*)(C.lds + 115200);
    LAS float* XS = (LAS float*)(C.lds + 105728);
    if (wv < 4) {
        GP_IDX(); const int base = 16 * wv, cc = lane & 15;
        float tc[16];
#pragma unroll
        for (int i2 = 0; i2 < 16; ++i2) { float a = (i2 == cc) ? 1.f : 0.f;
#pragma unroll
            for (int j = 0; j < i2; ++j) a -= LM[(base + i2) * 65 + base + j] * tc[j];
            tc[i2] = a; }
        if (lane < 16) {
#pragma unroll
            for (int i2 = 0; i2 < 16; ++i2) TM[(base + i2) * 65 + base + cc] = tc[i2]; }
    }
    __syncthreads();
#pragma unroll
    for (int I = 1; I < 4; ++I) {
        if (wv < I) {
            GP_IDX(); const int J = wv;
            f32x4 X = (f32x4){0.f, 0.f, 0.f, 0.f};
            for (int K = J; K < I; ++K) {
#pragma unroll
                for (int kk = 0; kk < 4; ++kk) { const float av = LM[(16 * I + r) * 65 + 16 * K + 4 * kk + q], bv = TM[(16 * K + 4 * kk + q) * 65 + 16 * J + r];
                    X = __builtin_amdgcn_mfma_f32_16x16x4f32(av, bv, X, 0, 0, 0); }
            }
            LAS float* xs = XS + wv * 272;
#pragma unroll
            for (int t = 0; t < 4; ++t) xs[(4 * q + t) * 17 + r] = X[t];
            LDS_WAIT(); asm volatile("" ::: "memory");
            f32x4 Y = (f32x4){0.f, 0.f, 0.f, 0.f};
#pragma unroll
            for (int kk = 0; kk < 4; ++kk) { const float av = TM[(16 * I + r) * 65 + 16 * I + 4 * kk + q], bv = xs[(4 * kk + q) * 17 + r];
                Y = __builtin_amdgcn_mfma_f32_16x16x4f32(av, bv, Y, 0, 0, 0); }
#pragma unroll
            for (int t = 0; t < 4; ++t) TM[(16 * I + 4 * q + t) * 65 + 16 * J + r] = -Y[t];
        }
        __syncthreads();
    }
    {
        GP_IDX(); const int i = tid >> 3;
        const int j0 = (tid & 7) * 8; float tv[8];
#pragma unroll
        for (int x = 0; x < 8; ++x) tv[x] = (j0 + x <= i) ? TM[i * 65 + j0 + x] : 0.f;
        *(LAS u32x4*)(TB + i * 72 + j0) = pack8f(tv);
    }
    __syncthreads();
    {
        GP_IDX();
        const int nt = wv;
        bf16x8 va[2], ka[2];
#pragma unroll
        for (int ks = 0; ks < 2; ++ks) { va[ks] = *(const LAS bf16x8*)(VBT + (16 * nt + r) * 72 + 32 * ks + 8 * q); ka[ks] = *(const LAS bf16x8*)(KBGT + (16 * nt + r) * 72 + 32 * ks + 8 * q); }
#pragma unroll
        for (int mt = 0; mt < 4; ++mt) {
            bf16x8 tf[2];
#pragma unroll
            for (int ks = 0; ks < 2; ++ks) tf[ks] = *(const LAS bf16x8*)(TB + (16 * mt + r) * 72 + 32 * ks + 8 * q);
            f32x4 au = (f32x4){0.f, 0.f, 0.f, 0.f}, aw = au;
            au = mfma16(va[0], tf[0], au); au = mfma16(va[1], tf[1], au);
            aw = mfma16(ka[0], tf[0], aw); aw = mfma16(ka[1], tf[1], aw);
            bf16* rowp = C.P + (size_t)(t0 + 16 * mt + r) * NP + h * 128 + 16 * nt + 4 * q;
            if (st) { *(u32x2*)(rowp + PV) = pack4(au); *(u32x2*)(rowp + PK) = pack4(aw); }
        }
    }
    __syncthreads();
#undef GP_IDX
}
__device__ __forceinline__ void ssd_prep_unit(const Ctx& C, int un2, bool stf = true) {
    const int tid = C.tid, lane = C.lane, wv = C.wave, r = lane & 15, q = lane >> 4;
    const int b = un2 >> 7, c = (un2 >> 1) & 63, gg = un2 & 1;
    const int t0 = b * T + c * 128;
    LAS bf16* CS = (LAS bf16*)(C.lds + 0);
    LAS bf16* BS = (LAS bf16*)(C.lds + 34816);
    LAS bf16* BTS = (LAS bf16*)(C.lds + 69632);
    const int l = tid >> 2, n0 = (tid & 3) * 32;
#pragma unroll
    for (int tensor = 0; tensor < 2; ++tensor) {
        const int colP = (tensor ? PC : PB) + gg * 128 + n0, ch = 1024 + tensor * 256 + gg * 128 + n0;
        float acc[32];
#pragma unroll
        for (int j = 0; j < 8; ++j) { const f32x4 bv = *(const f32x4*)(C.ssm_conv_b + ch + 4 * j); acc[4 * j] = bv[0]; acc[4 * j + 1] = bv[1]; acc[4 * j + 2] = bv[2]; acc[4 * j + 3] = bv[3]; }
#pragma unroll
        for (int kk = 0; kk < 4; ++kk) {
            const int rl = c * 128 + l - 3 + kk;
            if (rl >= 0) {
                const u32x4* s = (const u32x4*)(C.P + (size_t)(b * T + rl) * NP + colP);
                const f32x4* wp = (const f32x4*)(C.ssm_conv_w + (size_t)kk * 1536 + ch);
#pragma unroll
                for (int j = 0; j < 4; ++j) { float xv[8]; unpack8(s[j], xv); const f32x4 w0 = wp[2 * j], w1 = wp[2 * j + 1];
#pragma unroll
                    for (int e = 0; e < 4; ++e) { acc[8 * j + e] += w0[e] * xv[e]; acc[8 * j + 4 + e] += w1[e] * xv[4 + e]; } }
            }
            asm volatile("" ::: "memory");
        }
#pragma unroll
        for (int x = 0; x < 32; ++x) acc[x] = silu_f(acc[x]);
        LAS bf16* dst = (tensor ? CS : BS) + l * 136 + n0;
#pragma unroll
        for (int j = 0; j < 4; ++j) { const u32x4 w = pack8f(acc + 8 * j); *(LAS u32x4*)(dst + 8 * j) = w;
            if (tensor && stf) *(u32x4*)(C.Cc + (size_t)(t0 + l) * 256 + gg * 128 + n0 + 8 * j) = w; }
        if (!tensor) {
#pragma unroll
            for (int x = 0; x < 32; ++x) BTS[(n0 + x) * 136 + l] = f2bf(acc[x]);
        }
    }
    __syncthreads();
    {
        bf16x8 cf[4];
#pragma unroll
        for (int ks = 0; ks < 4; ++ks) cf[ks] = *(const LAS bf16x8*)(CS + (16 * wv + r) * 136 + 32 * ks + 8 * q);
#pragma unroll
        for (int st = 0; st < 8; ++st) {
            f32x4 acc = (f32x4){0.f, 0.f, 0.f, 0.f};
#pragma unroll
            for (int ks = 0; ks < 4; ++ks) { const bf16x8 bfr = *(const LAS bf16x8*)(BS + (16 * st + r) * 136 + 32 * ks + 8 * q); acc = mfma16(bfr, cf[ks], acc); }
            if (stf) *(u32x2*)(C.CB + ((size_t)un2 * 128 + 16 * wv + r) * 128 + 16 * st + 4 * q) = pack4(acc);
        }
        for (int ch = tid; ch < 2048; ch += 512) { const int n = ch >> 4, part = ch & 15;
            const u32x4 bv_ = *(const LAS u32x4*)(BTS + n * 136 + part * 8); if (stf) *(u32x4*)(C.BT + ((size_t)un2 * 128 + n) * 128 + part * 8) = bv_; }
    }
    __syncthreads();
}

template <int NE>
__device__ __forceinline__ void gdn_scan(const Ctx& C, int bh, int eb, bool st = true) {
    const int tid = C.tid, lane = C.lane, wv = C.wave, r = lane & 15, q = lane >> 4;
    const int b = bh >> 3, h = bh & 7, e0 = 16 * NE * eb;
    LAS bf16* ST = (LAS bf16*)(C.lds + 0);
    LAS bf16* VNT = (LAS bf16*)(C.lds + 16 * NE * 136 * 2);
    for (int idx = tid; idx < (16 * NE * (136 + 72) * 2) / 4; idx += 512) ((LAS unsigned*)C.lds)[idx] = 0u;
    f32x4 S[NE];
#pragma unroll
    for (int et = 0; et < NE; ++et) S[et] = (f32x4){0.f, 0.f, 0.f, 0.f};
    const int mt = wv & 3; const bool lead = wv < 4;
    const size_t rowA = ((size_t)b * T + 16 * mt + r) * NP + (lead ? PK : PQ) + h * 128 + 8 * q;
    const size_t rowU = ((size_t)b * T + 16 * mt + r) * NP + PV + h * 128 + e0 + 4 * q;
    const size_t offT = ((size_t)bh * 128 * 64 + 16 * mt + r) * 64 + 8 * q;
    const size_t offK = ((size_t)bh * 128 * 128 + 16 * wv + r) * 64 + 8 * q;
#define GS_DECL(k) bf16x8 af0_##k, af1_##k, af2_##k, af3_##k, at0_##k = {0,0,0,0,0,0,0,0}, at1_##k = {0,0,0,0,0,0,0,0}, kf0_##k, kf1_##k; u32x2 u_##k[NE]; float cd_##k;
#define GS_LOAD(k, cc) do { const size_t _c = (size_t)((cc) < 127 ? (cc) : 127); const bf16* _a = C.P + rowA + _c * 64 * NP; \
        af0_##k = *(const bf16x8*)(_a); af1_##k = *(const bf16x8*)(_a + 32); af2_##k = *(const bf16x8*)(_a + 64); af3_##k = *(const bf16x8*)(_a + 96); \
        if (lead) { _Pragma("unroll") for (int et = 0; et < NE; ++et) u_##k[et] = *(const u32x2*)(C.P + rowU + _c * 64 * NP + 16 * et); } \
        else { at0_##k = *(const bf16x8*)(C.attn + offT + _c * 4096); at1_##k = *(const bf16x8*)(C.attn + offT + _c * 4096 + 32); } \
        kf0_##k = *(const bf16x8*)(C.kdT + offK + _c * 8192); kf1_##k = *(const bf16x8*)(C.kdT + offK + _c * 8192 + 32); \
        cd_##k = C.cdv[bh * 128 + (int)_c]; } while (0)
#define GS_STEP(k, cc) do { \
        f32x4 acc[NE]; \
        _Pragma("unroll") for (int et = 0; et < NE; ++et) { const LAS bf16* sp = ST + (16 * et + r) * 136 + 8 * q; f32x4 a_ = (f32x4){0.f, 0.f, 0.f, 0.f}; \
          a_ = mfma16(*(const LAS bf16x8*)(sp), af0_##k, a_); a_ = mfma16(*(const LAS bf16x8*)(sp + 32), af1_##k, a_); \
          a_ = mfma16(*(const LAS bf16x8*)(sp + 64), af2_##k, a_); a_ = mfma16(*(const LAS bf16x8*)(sp + 96), af3_##k, a_); acc[et] = a_; }        \
        if (lead) { _Pragma("unroll") for (int et = 0; et < NE; ++et) { const u32x2 uu = u_##k[et]; const float u4[4] = {bflo(uu.x), bfhi(uu.x), bflo(uu.y), bfhi(uu.y)}; \
            LAS bf16* vp = VNT + (16 * et + 4 * q) * 72 + 16 * mt + r; \
            _Pragma("unroll") for (int t = 0; t < 4; ++t) vp[t * 72] = f2bf(u4[t] - acc[et][t]); } } \
        __syncthreads(); \
        _Pragma("unroll") for (int et = 0; et < NE; ++et) { \
            const bf16x8 vf0 = *(const LAS bf16x8*)(VNT + (16 * et + r) * 72 + 8 * q), vf1 = *(const LAS bf16x8*)(VNT + (16 * et + r) * 72 + 32 + 8 * q); \
            if (!lead) { f32x4 a_ = acc[et]; a_ = mfma16(vf0, at0_##k, a_); a_ = mfma16(vf1, at1_##k, a_); \
                if (st) *(u32x2*)(C.P + rowU + (size_t)(cc) * 64 * NP + 16 * et) = pack4(a_); }                    \
            f32x4 s_ = S[et] * cd_##k; \
            s_ = mfma16(kf0_##k, vf0, s_); s_ = mfma16(kf1_##k, vf1, s_); S[et] = s_;                             \
            *(LAS u32x2*)(ST + (16 * et + r) * 136 + 16 * wv + 4 * q) = pack4(s_); } \
        GS_LOAD(k, (cc) + 3); \
        __syncthreads(); } while (0)
    GS_DECL(0) GS_DECL(1) GS_DECL(2)
    GS_LOAD(0, 0); GS_LOAD(1, 1); GS_LOAD(2, 2);
    __syncthreads();
    for (int c = 0; c < 126; c += 3) { GS_STEP(0, c); GS_STEP(1, c + 1); GS_STEP(2, c + 2); }
    GS_STEP(0, 126); GS_STEP(1, 127);
#undef GS_DECL
#undef GS_LOAD
#undef GS_STEP
}
__device__ __forceinline__ void ssd_scan(const Ctx& C, int b, int hh, int pq, bool st = true) {
    const int tid = C.tid, lane = C.lane, wv = C.wave, r = lane & 15, q = lane >> 4;
    const int gg = hh >> 3, p0 = 16 * pq, l = 16 * wv + r, pc = p0 + 4 * q;
    LAS bf16* XDT = (LAS bf16*)(C.lds + 0);
    LAS bf16* XDS = (LAS bf16*)(C.lds + 4352);
    LAS bf16* HP = (LAS bf16*)(C.lds + 8704);
    LAS float* ACS = (LAS float*)(C.lds + 13056);
    LAS float* DTV = (LAS float*)(C.lds + 14080);
    LAS bf16* XH = (LAS bf16*)(C.lds + 15104);
    for (int idx = tid; idx < 4352 / 4; idx += 512) ((LAS unsigned*)(C.lds + 8704))[idx] = 0u;
    for (int idx = tid; idx < 192 / 4; idx += 512) ((LAS unsigned*)(C.lds + 15104))[idx] = 0u;
    f32x4 H = (f32x4){0.f, 0.f, 0.f, 0.f};
    const float Aneg = -expf(C.ssm_a_log[hh]), dtb = C.ssm_dt_bias[hh], Dsk = C.ssm_d[hh];
    f32x4 cw[4]; const f32x4 cbias = *(const f32x4*)(C.ssm_conv_b + hh * 64 + pc);
#pragma unroll
    for (int kk = 0; kk < 4; ++kk) cw[kk] = *(const f32x4*)(C.ssm_conv_w + (size_t)kk * 1536 + hh * 64 + pc);
    const size_t rowX = ((size_t)b * T + l) * NP + PXS + hh * 64 + pc;
    const size_t rowZ = ((size_t)b * T + l) * NP + PZS + hh * 64 + pc;
    const size_t offCB = (((size_t)b * 64) * 2 + gg) * 128 * 128 + (size_t)l * 128 + 8 * q;
    const size_t offCc = ((size_t)b * T + l) * 256 + gg * 128 + 8 * q;
    const size_t offDt = ((size_t)b * T + 2 * lane) * 32 + 16 + hh;
#define SS_DECL(k) u32x2 x0_##k, x1_##k, x2_##k, x3_##k, z_##k; bf16x8 cb0_##k, cb1_##k, cb2_##k, cb3_##k, cc0_##k, cc1_##k, cc2_##k, cc3_##k, bt0_##k, bt1_##k, bt2_##k, bt3_##k; float d0_##k = 0.f, d1_##k = 0.f;
#define SS_LOAD(k, cc) do { const size_t _c = (size_t)((cc) < 63 ? (cc) : 63); const bf16* _x = C.P + rowX + _c * 128 * NP; \
        x3_##k = *(const u32x2*)(_x); \
        x2_##k = (l >= 1) ? *(const u32x2*)(_x - NP) : (u32x2){0u, 0u}; x1_##k = (l >= 2) ? *(const u32x2*)(_x - 2 * NP) : (u32x2){0u, 0u}; x0_##k = (l >= 3) ? *(const u32x2*)(_x - 3 * NP) : (u32x2){0u, 0u}; \
        z_##k = *(const u32x2*)(C.P + rowZ + _c * 128 * NP); \
        const bf16* _cb = C.CB + offCB + _c * 32768; cb0_##k = *(const bf16x8*)(_cb); cb1_##k = *(const bf16x8*)(_cb + 32); cb2_##k = *(const bf16x8*)(_cb + 64); cb3_##k = *(const bf16x8*)(_cb + 96); \
        const bf16* _bt = C.BT + offCB + _c * 32768; bt0_##k = *(const bf16x8*)(_bt); bt1_##k = *(const bf16x8*)(_bt + 32); bt2_##k = *(const bf16x8*)(_bt + 64); bt3_##k = *(const bf16x8*)(_bt + 96); \
        const bf16* _cc = C.Cc + offCc + _c * 32768; cc0_##k = *(const bf16x8*)(_cc); cc1_##k = *(const bf16x8*)(_cc + 32); cc2_##k = *(const bf16x8*)(_cc + 64); cc3_##k = *(const bf16x8*)(_cc + 96); \
        if (wv == 7) { d0_##k = C.small[offDt + _c * 4096]; d1_##k = C.small[offDt + _c * 4096 + 32]; } } while (0)
#define SS_CUMSUM(k, buf) do { const float _dt0 = softplus_f(d0_##k + dtb), _dt1 = softplus_f(d1_##k + dtb); const float _a0 = _dt0 * Aneg, _a1 = _dt1 * Aneg; float _s = _a0 + _a1; const float _own = _s; \
        _Pragma("unroll") for (int _o = 1; _o < 64; _o <<= 1) { const float _v2 = __shfl_up(_s, _o); if (lane >= _o) _s += _v2; } \
        const float _ex = _s - _own; LAS float* _A = ACS + (buf) * 128 + 2 * lane; LAS float* _D = DTV + (buf) * 128 + 2 * lane; _A[0] = _ex + _a0; _A[1] = _ex + _a0 + _a1; _D[0] = _dt0; _D[1] = _dt1; } while (0)
#define SS_STEP(k, kn, cc) do { const int pb = (k); \
        u32x2 x0 = x0_##k, x1 = x1_##k, x2 = x2_##k; const u32x2 x3 = x3_##k; \
        if (l < 3) { const LAS bf16* xh = XH + (pb ^ 1) * 48 + 4 * q; \
            if (l < 1) x2 = *(const LAS u32x2*)(xh + 2 * 16); if (l < 2) x1 = *(const LAS u32x2*)(xh + (1 + l) * 16); x0 = *(const LAS u32x2*)(xh + l * 16); } \
        float xs[4]; \
        { const float a0[4] = {bflo(x0.x), bfhi(x0.x), bflo(x0.y), bfhi(x0.y)}, a1[4] = {bflo(x1.x), bfhi(x1.x), bflo(x1.y), bfhi(x1.y)}; \
          const float a2[4] = {bflo(x2.x), bfhi(x2.x), bflo(x2.y), bfhi(x2.y)}, a3[4] = {bflo(x3.x), bfhi(x3.x), bflo(x3.y), bfhi(x3.y)}; \
          _Pragma("unroll") for (int t = 0; t < 4; ++t) xs[t] = silu_f(cbias[t] + cw[0][t] * a0[t] + cw[1][t] * a1[t] + cw[2][t] * a2[t] + cw[3][t] * a3[t]); } \
        const float al = ACS[pb * 128 + l], alast = ACS[pb * 128 + 127]; \
        { const float dtl = DTV[pb * 128 + l], ed = expf(alast - al); \
          LAS bf16* xt = XDT + (4 * q) * 136 + l; LAS bf16* xd = XDS + (4 * q) * 136 + l; \
          _Pragma("unroll") for (int t = 0; t < 4; ++t) { const float v = xs[t] * dtl; xt[t * 136] = f2bf(v); xd[t * 136] = f2bf(v * ed); } \
          if (l >= 125) *(LAS u32x2*)(XH + pb * 48 + (l - 125) * 16 + 4 * q) = x3; } \
        __syncthreads(); \
        { const LAS float* acs = ACS + pb * 128; \
          bf16x8 sf[4]; \
          _Pragma("unroll") for (int ks = 0; ks < 4; ++ks) { \
              const bf16x8 cbk = ks == 0 ? cb0_##k : (ks == 1 ? cb1_##k : (ks == 2 ? cb2_##k : cb3_##k)); \
              float cbv[8]; unpack8(__builtin_bit_cast(u32x4, cbk), cbv); \
              const f32x4 s0 = *(const LAS f32x4*)(acs + 32 * ks + 8 * q), s1 = *(const LAS f32x4*)(acs + 32 * ks + 8 * q + 4); \
              _Pragma("unroll") for (int x = 0; x < 8; ++x) { const int s = 32 * ks + 8 * q + x; const float as = x < 4 ? s0[x & 3] : s1[x & 3]; cbv[x] = (s <= l) ? cbv[x] * expf(al - as) : 0.f; } \
              sf[ks] = __builtin_bit_cast(bf16x8, pack8f(cbv)); } \
          f32x4 yd = (f32x4){0.f, 0.f, 0.f, 0.f}, yo = yd, Hn = yd; \
          const LAS bf16* xp = XDT + r * 136 + 8 * q; const LAS bf16* hp = HP + r * 136 + 8 * q; const LAS bf16* dp = XDS + r * 136 + 8 * q; \
          yd = mfma16(*(const LAS bf16x8*)(xp), sf[0], yd); yd = mfma16(*(const LAS bf16x8*)(xp + 32), sf[1], yd); yd = mfma16(*(const LAS bf16x8*)(xp + 64), sf[2], yd); yd = mfma16(*(const LAS bf16x8*)(xp + 96), sf[3], yd); \
          yo = mfma16(*(const LAS bf16x8*)(hp), cc0_##k, yo); yo = mfma16(*(const LAS bf16x8*)(hp + 32), cc1_##k, yo); yo = mfma16(*(const LAS bf16x8*)(hp + 64), cc2_##k, yo); yo = mfma16(*(const LAS bf16x8*)(hp + 96), cc3_##k, yo); \
          Hn = mfma16(bt0_##k, *(const LAS bf16x8*)(dp), Hn); Hn = mfma16(bt1_##k, *(const LAS bf16x8*)(dp + 32), Hn); Hn = mfma16(bt2_##k, *(const LAS bf16x8*)(dp + 64), Hn); Hn = mfma16(bt3_##k, *(const LAS bf16x8*)(dp + 96), Hn); \
          const float eal = expf(al); \
          const float z4[4] = {bflo(z_##k.x), bfhi(z_##k.x), bflo(z_##k.y), bfhi(z_##k.y)}; \
          f32x4 o; \
          _Pragma("unroll") for (int t = 0; t < 4; ++t) { const float y = yd[t] + eal * yo[t] + xs[t] * Dsk; o[t] = y * silu_f(z4[t]); } \
          if (st) *(u32x2*)(C.P + rowX + (size_t)(cc) * 128 * NP) = pack4(o); \
          H = H * expf(alast) + Hn; \
          if (wv == 7) SS_CUMSUM(kn, pb ^ 1); } \
        SS_LOAD(k, (cc) + 2); \
        __syncthreads(); \
        *(LAS u32x2*)(HP + r * 136 + 16 * wv + 4 * q) = pack4(H); } while (0)
    SS_DECL(0) SS_DECL(1)
    SS_LOAD(0, 0); SS_LOAD(1, 1);
    if (wv == 7) SS_CUMSUM(0, 0);
    __syncthreads();
    for (int c = 0; c < 64; c += 2) { SS_STEP(0, 1, c); SS_STEP(1, 0, c + 1); }
    __syncthreads();
#undef SS_DECL
#undef SS_LOAD
#undef SS_CUMSUM
#undef SS_STEP
}

__device__ __forceinline__ void p4_finish(const Ctx& C) {
    const int gw = C.vcu * NWAVES + C.wave, NGW = C.G * NWAVES, lane = C.lane, c0 = 16 * lane;
    for (int m = gw; m < M; m += NGW) {
        const bf16* prow = C.P + (size_t)m * NP;
        {
            float o[16], z[16]; const u32x4* op = (const u32x4*)(prow + PV + c0); const u32x4* zp = (const u32x4*)(prow + PZG + c0);
            unpack8(op[0], o); unpack8(op[1], o + 8); unpack8(zp[0], z); unpack8(zp[1], z + 8);
            float ss = 0.f;
#pragma unroll
            for (int x = 0; x < 16; ++x) ss += o[x] * o[x];
            ss += __shfl_xor(ss, 1); ss += __shfl_xor(ss, 2); ss += __shfl_xor(ss, 4);
            const float rs = rsqrtf(ss * (1.f / 128.f) + EPS);
            const f32x4* nw = (const f32x4*)(C.gdn_norm_w + (c0 & 127));
#pragma unroll
            for (int j = 0; j < 4; ++j) { const f32x4 w = nw[j];
#pragma unroll
                for (int e = 0; e < 4; ++e) o[4 * j + e] = o[4 * j + e] * rs * w[e] * silu_f(z[4 * j + e]); }
            u32x4* mp = (u32x4*)(C.mix + (size_t)m * MIXD + c0); mp[0] = pack8f(o); mp[1] = pack8f(o + 8);
        }
        {
            float y[16]; const u32x4* yp = (const u32x4*)(prow + PXS + c0); unpack8(yp[0], y); unpack8(yp[1], y + 8);
            float ss = 0.f;
#pragma unroll
            for (int x = 0; x < 16; ++x) ss += y[x] * y[x];
            ss += __shfl_xor(ss, 1); ss += __shfl_xor(ss, 2); ss += __shfl_xor(ss, 4); ss += __shfl_xor(ss, 8); ss += __shfl_xor(ss, 16);
            const float rs = rsqrtf(ss * (1.f / 512.f) + EPS);
            const f32x4* nw = (const f32x4*)(C.ssm_norm_w + c0);
#pragma unroll
            for (int j = 0; j < 4; ++j) { const f32x4 w = nw[j];
#pragma unroll
                for (int e = 0; e < 4; ++e) y[4 * j + e] = y[4 * j + e] * rs * w[e]; }
            u32x4* mp = (u32x4*)(C.mix + (size_t)m * MIXD + 1024 + c0); mp[0] = pack8f(y); mp[1] = pack8f(y + 8);
        }
    }
}

__device__ __forceinline__ void attn_unit(const Ctx& C, int un) {
    const int wv = C.wave, tid = C.tid;
    const int pm = un >> 2, hd = un & 3, b = pm >> 5;
    const size_t tq0 = (size_t)pm * 256 + 32 * wv;
    LAS bf16* KS = (LAS bf16*)(C.lds);
    const char* Qb = (const char*)(C.qb + tq0 * 1024 + hd * 256);
    char* Ob = (char*)(C.ao + tq0 * 1024 + hd * 256);
    { const bf16* Kg = C.Kmem + (size_t)b * 256 * 1024 + hd * 256;
#pragma unroll 4
      for (int j = 0; j < 16; ++j) { const int p = tid + 512 * j, row = p >> 5, c16 = p & 31;
          *(LAS u32x4*)(KS + row * 264 + c16 * 8) = *(const u32x4*)(Kg + (size_t)row * 1024 + c16 * 8); } }
    __syncthreads();
    bf16x8 pf[2][8];
#pragma unroll
    for (int it = 0; it < 2; ++it) {
        const int lane = opaque(C.lane), r = lane & 15, q = lane >> 4;
        bf16x8 qf[8];
        const unsigned qoff = (unsigned)((16 * it + r) * 1024 + 8 * q) * 2u;
#pragma unroll
        for (int ks = 0; ks < 8; ++ks) qf[ks] = *(const bf16x8*)(Qb + qoff + 64 * ks);
        f32x4 sc[16];
        const LAS bf16* kp = KS + r * 264 + 8 * q;
#pragma unroll
        for (int mt = 0; mt < 16; ++mt) {
            f32x4 acc = (f32x4){0.f, 0.f, 0.f, 0.f};
#pragma unroll
            for (int ks = 0; ks < 8; ++ks) acc = mfma16(*(const LAS bf16x8*)(kp + mt * 16 * 264 + 32 * ks), qf[ks], acc);
            sc[mt] = acc;
        }
        float mx = -3.0e38f;
#pragma unroll
        for (int mt = 0; mt < 16; ++mt) mx = fmaxf(fmaxf(fmaxf(sc[mt][0], sc[mt][1]), fmaxf(sc[mt][2], sc[mt][3])), mx);
        mx = fmaxf(mx, __shfl_xor(mx, 16)); mx = fmaxf(mx, __shfl_xor(mx, 32));
        float sum = 0.f;
#pragma unroll
        for (int mt = 0; mt < 16; ++mt)
#pragma unroll
            for (int t = 0; t < 4; ++t) { const float e = __expf(sc[mt][t] - mx); sc[mt][t] = e; sum += e; }
        sum += __shfl_xor(sum, 16); sum += __shfl_xor(sum, 32);
        const float inv = 1.f / sum;
#pragma unroll
        for (int ks = 0; ks < 8; ++ks) { const f32x4 lo = sc[2 * ks] * inv, hi = sc[2 * ks + 1] * inv; u32x4 w; w.x = pk2(lo[0], lo[1]); w.y = pk2(lo[2], lo[3]); w.z = pk2(hi[0], hi[1]); w.w = pk2(hi[2], hi[3]);
            pf[it][ks] = __builtin_bit_cast(bf16x8, w); }
    }
    __syncthreads();
    { const bf16* Vg = C.VT + ((size_t)b * 1024 + hd * 256) * 256;
#pragma unroll 4
      for (int j = 0; j < 16; ++j) { const int p = tid + 512 * j, row = p >> 5, c16 = p & 31;
          *(LAS u32x4*)(KS + row * 264 + c16 * 8) = *(const u32x4*)(Vg + (size_t)row * 256 + c16 * 8); } }
    __syncthreads();
    {
        const int lane = opaque(C.lane), r = lane & 15, q = lane >> 4;
        const LAS bf16* vp = KS + r * 264 + 4 * q;
#pragma unroll 2
        for (int dt = 0; dt < 16; ++dt) {
            f32x4 a0 = (f32x4){0.f, 0.f, 0.f, 0.f}, a1 = a0;
#pragma unroll
            for (int ks = 0; ks < 8; ++ks) {
                const u32x2 v0 = *(const LAS u32x2*)(vp + dt * 16 * 264 + 32 * ks), v1 = *(const LAS u32x2*)(vp + dt * 16 * 264 + 32 * ks + 16);
                u32x4 w; w.x = v0.x; w.y = v0.y; w.z = v1.x; w.w = v1.y; const bf16x8 vf = __builtin_bit_cast(bf16x8, w);
                a0 = mfma16(vf, pf[0][ks], a0); a1 = mfma16(vf, pf[1][ks], a1);
            }
            *(u32x2*)(Ob + (unsigned)((r * 1024 + 16 * dt + 4 * q) * 2)) = pack4(a0);
            *(u32x2*)(Ob + (unsigned)(((16 + r) * 1024 + 16 * dt + 4 * q) * 2)) = pack4(a1);
        }
    }
    __syncthreads();
}

__device__ __forceinline__ void p11_final(const Ctx& C) {
    const int gw = C.vcu * NWAVES + C.wave, NGW = C.G * NWAVES, lane = C.lane;
    for (int m = gw; m < M; m += NGW) {
        f32x4* xr = (f32x4*)(C.out + (size_t)m * D) + lane; const f32x4* wr = (const f32x4*)C.final_norm_w + lane;
        f32x4 v[4]; float s = 0.f;
#pragma unroll
        for (int j = 0; j < 4; ++j) { v[j] = xr[64 * j]; s += (v[j][0] * v[j][0] + v[j][1] * v[j][1]) + (v[j][2] * v[j][2] + v[j][3] * v[j][3]); }
        const float rstd = rsqrtf(wave_sum(s) * (1.f / 1024.f) + EPS);
#pragma unroll
        for (int j = 0; j < 4; ++j) xr[64 * j] = v[j] * rstd * wr[64 * j];
    }
}


#ifdef DBG_CK
__device__ __forceinline__ float ck_sum(const bf16* p, size_t n16, int gw, int NGW, int lane) {
    float s = 0.f;
    for (size_t i = (size_t)gw * 64 + lane; i < n16; i += (size_t)NGW * 64) { float v[8]; unpack8(((const u32x4*)p)[i], v);
#pragma unroll
        for (int x = 0; x < 8; ++x) s += fabsf(v[x]) < 1e30f ? fabsf(v[x]) : 777.f; }
    return wave_sum(s);
}
__device__ __forceinline__ void dbg_ck_a(const Ctx& C) {
    const int gw = C.vcu * NWAVES + C.wave, NGW = C.G * NWAVES, lane = C.lane;
    float* ck = (float*)(C.ws + 255 * MiB + 512 * 1024);
    float r[8];
    r[0] = ck_sum(C.attn, (size_t)16 * MiB / 16, gw, NGW, lane);
    r[1] = ck_sum(C.kdT, (size_t)32 * MiB / 16, gw, NGW, lane);
    r[2] = ck_sum(C.BT, (size_t)8 * MiB / 16, gw, NGW, lane);
    r[3] = ck_sum(C.Cc, (size_t)8 * MiB / 16, gw, NGW, lane);
    r[4] = ck_sum(C.CB, (size_t)8 * MiB / 16, gw, NGW, lane);
    r[5] = C.cdv[gw]; r[6] = 0.f; r[7] = 0.f;
    if (lane < 8) { float v = 0.f;
#pragma unroll
        for (int x = 0; x < 8; ++x) if (lane == x) v = ((DBG_CK >> x) & 1) ? r[x] : 0.f;
        ck[gw * 8 + lane] = v; }
}
__device__ __forceinline__ void dbg_ck_b(const Ctx& C) {
    const float* ck = (const float*)(C.ws + 255 * MiB + 512 * 1024);
    for (size_t i = (size_t)C.bx * 512 + C.tid; i < (size_t)M * D; i += (size_t)C.G * 512) C.out[i] = ck[i & 16383];
}
#endif
#ifdef DBG_PHASE
__device__ __forceinline__ void dbg_digest(const Ctx& C) {
    const int gw = C.vcu * NWAVES + C.wave, NGW = C.G * NWAVES, lane = C.lane;
    for (int m = gw; m < M; m += NGW) {
        float acc[16];
#pragma unroll
        for (int x = 0; x < 16; ++x) acc[x] = 0.f;
        const int c0 = 16 * lane;
        if (DBG_PHASE <= 3) {
            const bf16* prow = C.P + (size_t)m * NP;
#pragma unroll
            for (int sct = 0; sct < 6; ++sct) { if (!((DBG_SEL >> sct) & 1)) continue; float v[16]; const u32x4* p = (const u32x4*)(prow + sct * 1024 + c0); unpack8(p[0], v); unpack8(p[1], v + 8);
#pragma unroll
                for (int x = 0; x < 16; ++x) acc[x] += v[x]; }
            if (lane < 32 && ((DBG_SEL >> 6) & 1)) { float v[16]; const u32x4* p = (const u32x4*)(prow + 6144 + c0); unpack8(p[0], v); unpack8(p[1], v + 8);
#pragma unroll
                for (int x = 0; x < 16; ++x) acc[x] += v[x]; }
            if (DBG_PHASE <= 2) {
#pragma unroll
                for (int x = 0; x < 16; ++x) acc[x] += C.small[(size_t)m * 32 + ((c0 + x) & 31)]; }
            else {
#pragma unroll
                for (int x = 0; x < 16; ++x) if ((DBG_SEL >> 7) & 1) acc[x] += C.ssm_ss[(size_t)m * 16 + x] * 1e-3f; }
        } else if (DBG_PHASE == 4) {
#pragma unroll
            for (int sct = 0; sct < 2; ++sct) { float v[16]; const u32x4* p = (const u32x4*)(C.mix + (size_t)m * MIXD + sct * 1024 + c0); unpack8(p[0], v); unpack8(p[1], v + 8);
#pragma unroll
                for (int x = 0; x < 16; ++x) acc[x] += v[x]; }
        } else if (DBG_PHASE == 5 || DBG_PHASE == 8) {
#pragma unroll
            for (int x = 0; x < 16; ++x) acc[x] = C.x1[(size_t)m * D + c0 + x];
        } else if (DBG_PHASE == 6 || DBG_PHASE == 7) {
            float v[16]; const u32x4* p = (const u32x4*)((DBG_PHASE == 6 ? C.qb : C.ao) + (size_t)m * D + c0); unpack8(p[0], v); unpack8(p[1], v + 8);
#pragma unroll
            for (int x = 0; x < 16; ++x) acc[x] = v[x];
        } else if (DBG_PHASE == 9) {
#pragma unroll
            for (int sct = 0; sct < 4; ++sct) { float v[16]; const u32x4* p = (const u32x4*)(C.hb + (size_t)m * FF + sct * 1024 + c0); unpack8(p[0], v); unpack8(p[1], v + 8);
#pragma unroll
                for (int x = 0; x < 16; ++x) acc[x] += v[x]; }
        }
        asm volatile("s_waitcnt vmcnt(0)" ::: "memory");
        float* orow = C.out + (size_t)m * D + c0;
#pragma unroll
        for (int x = 0; x < 16; ++x) orow[x] = (fabsf(acc[x]) < 1e30f) ? acc[x] : 12345.f;
    }
}
#endif

#ifndef MK_N_LAUNCHES
#define MK_N_LAUNCHES 1
#endif
constexpr int N_PHASES = 12;
#ifndef GDN_NE
#define GDN_NE 4
#endif
constexpr int N_LAUNCHES = MK_N_LAUNCHES;
struct Args { const float* in[25]; float* out; unsigned char* ws; int ph_lo, ph_hi; };
__global__ void __launch_bounds__(NWAVES * 64, 2) fwd_kernel(Args args) {
    extern __shared__ __attribute__((aligned(16))) unsigned char lds[];
    Ctx C;
    C.lds = (LAS unsigned char*)lds;
    C.tid = threadIdx.x; C.lane = C.tid & 63; C.wave = __builtin_amdgcn_readfirstlane(C.tid >> 6);
    C.G = gridDim.x; C.bx = blockIdx.x; C.vcu = (C.G % 8 == 0) ? (C.bx % 8) * (C.G / 8) + C.bx / 8 : C.bx;
    C.x = args.in[0]; C.mem = args.in[1]; C.norm1_w = args.in[2]; C.w_in = args.in[3]; C.gdn_conv_w = args.in[4]; C.gdn_a_log = args.in[5]; C.gdn_dt_bias = args.in[6]; C.gdn_norm_w = args.in[7];
    C.ssm_conv_w = args.in[8]; C.ssm_conv_b = args.in[9]; C.ssm_a_log = args.in[10]; C.ssm_dt_bias = args.in[11]; C.ssm_d = args.in[12]; C.ssm_norm_w = args.in[13]; C.w_out = args.in[14];
    C.norm2_w = args.in[15]; C.mem_norm_w = args.in[16]; C.wq = args.in[17]; C.wk = args.in[18]; C.wv = args.in[19]; C.wo = args.in[20]; C.norm3_w = args.in[21]; C.w_up = args.in[22];
    C.w_down = args.in[23]; C.final_norm_w = args.in[24];
    C.out = args.out; C.ws = args.ws; C.dob = (unsigned char*)args.out;
    unsigned char* ws = args.ws; unsigned char* dob = C.dob;
    C.P = (bf16*)(ws + WS_P); C.Win_t = (bf16*)(ws + WS_WIN); C.Wkv_t = (bf16*)(ws + WS_WKV); C.Wout_t = (bf16*)(ws + WS_WOUT); C.Wq_t = (bf16*)(ws + WS_WQ); C.Wo_t = (bf16*)(ws + WS_WO);
    C.Wup_t = (bf16*)(ws + WS_WUP); C.Wdn_t = (bf16*)(ws + WS_WDN); C.Kmem = (bf16*)(ws + WS_KMEM); C.VT = (bf16*)(ws + WS_VT); C.MN = (bf16*)(ws + WS_MN);
    C.XN1 = (bf16*)(dob + DO_XN1); C.halo = (bf16*)(dob + DO_HALO); C.kdT = (bf16*)(dob + DO_KDT); C.attn = (bf16*)(dob + DO_ATTN); C.BT = (bf16*)(dob + DO_BT);
    C.Cc = (bf16*)(ws + WS_CC); C.CB = (bf16*)(ws + WS_CB); C.mix = (bf16*)dob; C.x1b = (bf16*)(ws + WS_X1B); C.qb = (bf16*)(ws + WS_Q); C.ao = (bf16*)(ws + WS_AO); C.hb = (bf16*)(ws + WS_HB);
    C.small = (float*)(ws + WS_SMALL); C.cdv = (float*)(ws + WS_CDV); C.ssm_ss = (float*)(ws + WS_MN); C.ssp = (float*)(ws + WS_SMALL); C.x1 = (float*)(ws + WS_X1);
    for (int u = C.tid; u < (LDS_BYTES - MISC_OFF) / 4; u += NWAVES * 64) ((LAS unsigned*)(C.lds + MISC_OFF))[u] = 0u;
    __syncthreads();
    XcdBarrier bar; bar.bar = (unsigned*)(ws + WS_CTL) + CW_BAR; bar.x = 0; bar.st = nullptr;
    if (N_LAUNCHES == 1) bar = xcd_barrier_post((unsigned*)(ws + WS_CTL) + CW_BAR, (volatile LAS unsigned*)(C.lds + MISC_OFF) + 8);
    const int lo = args.ph_lo, hi = args.ph_hi;
#ifndef PH_MASK
#define PH_MASK 0xFFF
#endif
#define IN(k) (((PH_MASK >> (k)) & 1) && lo <= (k) && (k) < hi)
#ifndef REP_MASK
#define REP_MASK 0
#endif
#define NREP(k) (((REP_MASK >> (k)) & 1) ? 2 : 1)
#define SEAM(k) do { if (IN(k) && IN((k) + 1)) xcd_barrier(bar); } while (0)
#define STAMP_SKIP(k)
    LAS unsigned char* ring = (LAS unsigned char*)lds;
#ifdef PROBE_A
#define STAMP(k) do { if (C.bx == 0 && C.tid == 0) ((volatile LAS unsigned long long*)(C.lds + MISC_OFF + 64))[k] = __builtin_amdgcn_s_memrealtime(); } while (0)
#undef SEAM
#define SEAM(k) do { if (IN(k) && IN((k) + 1)) xcd_barrier(bar); STAMP((k) + 1); } while (0)
    STAMP(0);
#endif

    if (IN(0)) { p0_prologue(C, 0, C.vcu * NWAVES + C.wave, C.G * NWAVES); } SEAM(0);
    if (IN(1)) for (int rep = 0; rep < NREP(1); ++rep) {
        { pg8::Gemm g{C.XN1, C.Win_t, M, NIN, D}; pg8::StaticOrder S; S.init(M, NIN, C.G, C.bx);
          pg8::EpiIn E{C.P, C.small, C.halo};
          pg8::gemm_phase<pg8::EpiIn, pg8::StaticOrder, true, true>(ring, g, S, E); }
        __syncthreads();
        { pg8::Gemm g{C.MN, C.Wkv_t, BATCH * MEMLEN, 2048, D}; pg8::StaticOrder S; S.init(BATCH * MEMLEN, 2048, C.G, C.G - 1 - C.bx);
          pg8::EpiKV E{C.Kmem, C.VT};
          pg8::gemm_phase<pg8::EpiKV, pg8::StaticOrder, true, true>(ring, g, S, E); }
    } SEAM(1);
    if (IN(2)) {
        for (int rep = 0; rep < NREP(2); ++rep) { const bool stf = (rep == NREP(2) - 1) || (hi < 0);
        for (int un = C.vcu; un < 2048; un += C.G) gdn_prep_unit(C, un, stf);
        for (int un2 = C.vcu; un2 < 256; un2 += C.G) ssd_prep_unit(C, un2, stf); }
    } SEAM(2);
    if (IN(3)) {
        for (int rep = 0; rep < NREP(3); ++rep) { const bool stf = (rep == NREP(3) - 1) || (hi < 0);
        constexpr int NE = GDN_NE, NGW = 128 / NE;
        if (C.bx < NGW) { const int xx = C.bx & 7, yy = C.bx >> 3;
#ifdef DRY_GDN
            gdn_scan<NE>(C, xx + 8 * (yy / (8 / NE)), yy % (8 / NE), hi < 0); __syncthreads();
#endif
            gdn_scan<NE>(C, xx + 8 * (yy / (8 / NE)), yy % (8 / NE), stf); }
        else if (C.bx < NGW + 128) { const int s = C.bx - NGW, combo = s & 3, idx = s >> 2;
#ifdef DRY_SSD
            ssd_scan(C, combo >> 1, (combo & 1) * 8 + (idx >> 2), idx & 3, hi < 0); __syncthreads();
#endif
            ssd_scan(C, combo >> 1, (combo & 1) * 8 + (idx >> 2), idx & 3, stf); }
        else { p0_prologue(C, 1, (C.bx - (NGW + 128)) * NWAVES + C.wave, (C.G - (NGW + 128)) * NWAVES); }
        __syncthreads(); }
    } SEAM(3);
    if (IN(4)) { for (int rep = 0; rep < NREP(4); ++rep) p4_finish(C); } SEAM(4);
    if (IN(5)) for (int rep = 0; rep < NREP(5); ++rep) {
        pg8::Gemm g{C.mix, C.Wout_t, M, D, MIXD}; pg8::StaticOrder S; S.init(M, D, C.G, C.bx);
        pg8::EpiRes E{C.x, C.x1, C.x1b, C.ssp};
        pg8::gemm_phase<pg8::EpiRes, pg8::StaticOrder, true, true>(ring, g, S, E);
    } SEAM(5);
    if (IN(6)) {
        pg8::Gemm g{C.x1b, C.Wq_t, M, D, D}; pg8::StaticOrder S; S.init(M, D, C.G, C.bx);
        pg8::EpiScale<0> E{C.qb, D, C.ssp, 0.0625f};
        pg8::gemm_phase<pg8::EpiScale<0>, pg8::StaticOrder, true, true>(ring, g, S, E);
        asm volatile("s_waitcnt vmcnt(0)" ::: "memory"); __syncthreads();
        pg8::Unit u; if (S.next(0, u)) attn_unit(C, u.pm * 4 + u.pn);
    }
    STAMP_SKIP(6);
    SEAM(7);
    if (IN(8)) {
        pg8::Gemm g{C.ao, C.Wo_t, M, D, D}; pg8::StaticOrder S; S.init(M, D, C.G, C.bx);
        pg8::EpiRes E{C.x1, C.x1, C.x1b, C.ssp};
        pg8::gemm_phase<pg8::EpiRes, pg8::StaticOrder, true, true>(ring, g, S, E);
    } SEAM(8);
    if (IN(9)) for (int rep = 0; rep < NREP(9); ++rep) {
        pg8::Gemm g{C.x1b, C.Wup_t, M, FF, D}; pg8::StaticOrder S; S.init(M, FF, C.G, C.bx);
        pg8::EpiScale<1> E{C.hb, FF, C.ssp, 1.0f};
        pg8::gemm_phase<pg8::EpiScale<1>, pg8::StaticOrder, true, true>(ring, g, S, E);
    } SEAM(9);
    if (IN(10)) for (int rep = 0; rep < NREP(10); ++rep) {
        pg8::Gemm g{C.hb, C.Wdn_t, M, D, FF}; pg8::StaticOrder S; S.init(M, D, C.G, C.bx);
        pg8::EpiRes E{C.x1, C.out, nullptr, nullptr};
        pg8::gemm_phase<pg8::EpiRes, pg8::StaticOrder, true, true>(ring, g, S, E);
    } SEAM(10);
#ifdef DBG_CK
    if (lo == 10) { dbg_ck_a(C); }
    if (lo == 11) { dbg_ck_b(C); }
#elif defined(DBG_PHASE)
    if (lo == 11) { dbg_digest(C); }
#else
    if (IN(11)) { p11_final(C); }
#endif
#ifdef PROBE_A
    xcd_barrier(bar); STAMP(12);
    if (C.bx == 0) {
        __syncthreads();
        volatile LAS unsigned long long* st = (volatile LAS unsigned long long*)(C.lds + MISC_OFF + 64);
        const float ta = (float)(st[PROBE_A + 1] - st[PROBE_A]) * 0.01f, tb = (float)(st[PROBE_B + 1] - st[PROBE_B]) * 0.01f;
        for (int i = C.tid; i < (1 << 20); i += 512) C.out[i] += (i == 0) ? (ta + tb) : tb;
    }
#endif
#undef IN
#undef SEAM
}

extern "C" void kernel_launch(void* const* d_in, const int* in_sizes, int n_in, void* d_out, int out_size, void* d_ws, size_t ws_size, hipStream_t stream) {
    static int grid = 0;
    if (grid == 0) {
        if (n_in != 25 || in_sizes[0] != M * D || out_size != M * D || ws_size < 256 * MiB) { fprintf(stderr, "kernel_launch: unexpected problem shape (n_in %d, in0 %d, out %d, ws %zu); nothing launched\n", n_in, n_in > 0 ? in_sizes[0] : -1, out_size, ws_size); grid = -1; return; }
        int dev = 0, cus = 0, per_cu = 0;
        if (hipGetDevice(&dev) != hipSuccess || hipDeviceGetAttribute(&cus, hipDeviceAttributeMultiprocessorCount, dev) != hipSuccess) { grid = -1; return; }
        if (hipFuncSetAttribute((const void*)fwd_kernel, hipFuncAttributeMaxDynamicSharedMemorySize, LDS_BYTES) != hipSuccess) { fprintf(stderr, "kernel_launch: hipFuncSetAttribute failed\n"); grid = -1; return; }
        if (hipOccupancyMaxActiveBlocksPerMultiprocessor(&per_cu, (const void*)fwd_kernel, NWAVES * 64, LDS_BYTES) != hipSuccess || per_cu < 1)
            fprintf(stderr, "kernel_launch: note: occupancy query reports %d workgroups per CU\n", per_cu);
        (void)hipGetLastError();
        grid = cus;
        if (grid != 256) fprintf(stderr, "kernel_launch: note: %d CUs (built for 256)\n", grid);
    }
    if (grid < 0) return;
    if (hipMemsetAsync((char*)d_ws + WS_CTL, 0, CTL_ZERO_BYTES, stream) != hipSuccess) { fprintf(stderr, "kernel_launch: hipMemsetAsync failed\n"); return; }
    Args a{};
    for (int i = 0; i < 25; ++i) a.in[i] = (const float*)d_in[i];
    a.out = (float*)d_out; a.ws = (unsigned char*)d_ws;
    if (N_LAUNCHES == 1) {
        a.ph_lo = 0; a.ph_hi = N_PHASES;
        hipLaunchKernelGGL(fwd_kernel, dim3(grid), dim3(NWAVES * 64), LDS_BYTES, stream, a);
    } else {
        for (int li = 0; li < N_PHASES; ++li) {
#ifdef DBG_PHASE
#ifdef DBG_CK
            if (li > DBG_PHASE && li < 10) continue;
#else
            if (li > DBG_PHASE && li != 11) continue;
#endif
#endif
            a.ph_lo = li; a.ph_hi = li + 1; hipLaunchKernelGGL(fwd_kernel, dim3(grid), dim3(NWAVES * 64), LDS_BYTES, stream, a); }
    }
    const hipError_t le = hipPeekAtLastError();
    if (le != hipSuccess) fprintf(stderr, "kernel_launch: launch failed: %s\n", hipGetErrorName(le));
}
```
